# Optimizing an MI355X kernel written in HIP

```python
import math
import jax
import jax.numpy as jnp
from jax import lax
import numpy as np

D_MODEL = 2048
BATCH = 2
SEQ = 16384
DEPTH = 4
DEC_BATCH = 8
DEC_SEQ = 64
PAST_LEN = 1024

CHUNK = 64
Q_BLOCK = 128
N_SEGMENTS = 16
A_HEADS = 4
A_NOPE = 128
A_ROPE = 64
A_VDIM = 128
Q_LORA = 512
KV_LORA = 512
ROPE_THETA = 10000.0
B_HEADS = 4
B_DIM = 128
B_PREV_CHUNKS = 8
B_PAST = B_PREV_CHUNKS * CHUNK
B_REL_CLIP = 128
C_HEADS = 4
C_DIM = 128
HEAD_DIM_OUT = 128
N_OUT_HEADS = A_HEADS + B_HEADS + C_HEADS
MIX_WIDTH = N_OUT_HEADS * HEAD_DIM_OUT
D_FF = 5632
CONV_W = 3
EPS = 1e-6

B_WIDTH = B_HEADS * B_DIM
C_WIDTH = C_HEADS * C_DIM
IN_WIDTH = Q_LORA + KV_LORA + A_ROPE + 3 * B_WIDTH + 3 * C_WIDTH
IN_SPLITS = [Q_LORA, Q_LORA + KV_LORA, Q_LORA + KV_LORA + A_ROPE, Q_LORA + KV_LORA + A_ROPE + 3 * B_WIDTH]
A_SCALE = 1.0 / math.sqrt(A_NOPE + A_ROPE)
B_SCALE = 1.0 / math.sqrt(B_DIM)
C_SCALE = 1.0 / math.sqrt(C_DIM)

kernel_name = 'hybrid_mla_band_stickbreak_convffn_stream_step'


def rmsnorm(x, g):
    xf = x.astype(jnp.float32)
    y = xf * lax.rsqrt(jnp.mean(xf * xf, axis=-1, keepdims=True) + EPS)
    return (y * g.astype(jnp.float32)).astype(x.dtype)


def rope(x, pos):
    half = x.shape[-1] // 2
    inv = ROPE_THETA ** (-jnp.arange(half, dtype=jnp.float32) / half)
    ang = pos.astype(jnp.float32)[:, None] * inv[None, :]
    ang = ang.reshape(ang.shape[:1] + (1,) * (x.ndim - 3) + (half,))
    cos, sin = jnp.cos(ang), jnp.sin(ang)
    xf = x.astype(jnp.float32)
    x1, x2 = xf[..., :half], xf[..., half:]
    return jnp.concatenate([x1 * cos - x2 * sin, x1 * sin + x2 * cos], axis=-1).astype(x.dtype)


def key_positions(pos, n_past):
    past = pos[0] - n_past + jnp.arange(n_past, dtype=jnp.int32)
    return jnp.concatenate([past, pos])


def sweep_queries(attend, q_parts, q_pos, n_past):
    n_q = q_pos.shape[0]
    if n_q <= Q_BLOCK:
        return attend(q_parts, q_pos, n_past + n_q)
    nb = n_q // Q_BLOCK
    n_seg = min(N_SEGMENTS, nb)
    bounds = [(i * nb) // n_seg for i in range(n_seg + 1)]
    outs = []
    for b0, b1 in zip(bounds[:-1], bounds[1:]):
        nblk = b1 - b0
        lo, hi = b0 * Q_BLOCK, b1 * Q_BLOCK
        blocks = tuple(jnp.moveaxis(t[:, lo:hi].reshape((t.shape[0], nblk, Q_BLOCK) + t.shape[2:]), 1, 0)
                       for t in q_parts)
        out = lax.map(lambda a, e=n_past + hi: attend(a[0], a[1], e),
                      (blocks, q_pos[lo:hi].reshape(nblk, Q_BLOCK)))
        out = jnp.moveaxis(out, 0, 1)
        outs.append(out.reshape((out.shape[0], nblk * Q_BLOCK) + out.shape[3:]))
    return jnp.concatenate(outs, axis=1)


def mla_attend(q, q_pos, k, v, k_pos):
    s = jnp.einsum('bqhd,bkhd->bhqk', q, k).astype(jnp.float32) * A_SCALE
    mask = (k_pos[None, :] // CHUNK) <= (q_pos[:, None] // CHUNK)
    s = jnp.where(mask, s, -jnp.inf)
    e = jnp.exp(s - jnp.max(s, axis=-1, keepdims=True))
    denom = jnp.transpose(jnp.sum(e, axis=-1), (0, 2, 1))[..., None]
    o = jnp.einsum('bhqk,bkhd->bqhd', e.astype(v.dtype), v)
    return (o.astype(jnp.float32) / denom).astype(v.dtype)


def band_attend(q, k, v, q_pos, k_pos, valid, rel_bias):
    s = jnp.einsum('bnqhd,bnkhd->bnhqk', q, k).astype(jnp.float32) * B_SCALE
    rel = jnp.clip(q_pos[:, None] - k_pos[None, :], -B_REL_CLIP, B_REL_CLIP) + B_REL_CLIP
    s = s + rel_bias[:, rel].astype(jnp.float32)[None, None]
    qc, kc = q_pos // CHUNK, k_pos // CHUNK
    band = (kc[None, :] <= qc[:, None]) & (kc[None, :] >= qc[:, None] - B_PREV_CHUNKS)
    mask = band[None, None, None] & valid[None, :, None, None, :]
    p = jax.nn.softmax(jnp.where(mask, s, -jnp.inf), axis=-1)
    return jnp.einsum('bnhqk,bnkhd->bnqhd', p.astype(v.dtype), v)


def band_prompt(q, k, v, rel_bias):
    n_b, n_t, n_h, d = q.shape
    nc = n_t // CHUNK
    idx = jnp.arange(nc)[:, None] + jnp.arange(B_PREV_CHUNKS + 1)[None, :]

    def gather_band(t):
        tc = jnp.pad(t.reshape(n_b, nc, CHUNK, n_h, d), ((0, 0), (B_PREV_CHUNKS, 0), (0, 0), (0, 0), (0, 0)))
        return tc[:, idx].reshape(n_b, nc, (B_PREV_CHUNKS + 1) * CHUNK, n_h, d)

    q_pos = B_PAST + jnp.arange(CHUNK, dtype=jnp.int32)
    k_pos = jnp.arange((B_PREV_CHUNKS + 1) * CHUNK, dtype=jnp.int32)
    valid = jnp.repeat(idx >= B_PREV_CHUNKS, CHUNK, axis=1)
    out = band_attend(q.reshape(n_b, nc, CHUNK, n_h, d), gather_band(k), gather_band(v), q_pos, k_pos, valid, rel_bias)
    return out.reshape(n_b, n_t, n_h, d)


def band_sample(q, k, v, k_past, v_past, pos, rel_bias):
    k_pos = key_positions(pos, k_past.shape[1])
    k_all = jnp.concatenate([k_past, k], axis=1)[:, None]
    v_all = jnp.concatenate([v_past, v], axis=1)[:, None]
    valid = (k_pos >= 0)[None]
    return band_attend(q[:, None], k_all, v_all, pos, k_pos, valid, rel_bias)[:, 0]


def rev_cumsum_keys(L):
    n_k = L.shape[-1]
    pad = (-n_k) % Q_BLOCK
    Lp = jnp.pad(L, [(0, 0)] * (L.ndim - 1) + [(0, pad)])
    nk = Lp.shape[-1] // Q_BLOCK
    Lb = Lp.reshape(L.shape[:-1] + (nk, Q_BLOCK))
    ar = jnp.arange(Q_BLOCK)
    tri = (ar[None, :] >= ar[:, None]).astype(L.dtype)
    within = jnp.einsum('...nj,sj->...ns', Lb, tri, precision=lax.Precision.HIGHEST)
    an = jnp.arange(nk)
    tri_n = (an[None, :] > an[:, None]).astype(L.dtype)
    after = jnp.einsum('...n,mn->...m', jnp.sum(Lb, axis=-1), tri_n, precision=lax.Precision.HIGHEST)
    return (within + after[..., None]).reshape(Lp.shape)[..., :n_k]


def sb_attend(q, q_pos, k, v, k_pos):
    z = jnp.einsum('bqhd,bkhd->bhqk', q, k).astype(jnp.float32) * C_SCALE
    causal = k_pos[None, :] < q_pos[:, None]
    log_keep = jnp.where(causal, jax.nn.log_sigmoid(-z), 0.0)
    log_w = z + rev_cumsum_keys(log_keep)
    w = jnp.exp(jnp.where(causal, log_w, -jnp.inf))
    return jnp.einsum('bhqk,bkhd->bqhd', w.astype(v.dtype), v)


def conv_ffn(h, conv_past, w_up, w_conv, b_conv, w_down):
    n_t = h.shape[1]
    u = jnp.concatenate([conv_past, h @ w_up], axis=1)
    c = b_conv
    for i in range(CONV_W):
        c = c + w_conv[i] * u[:, i:i + n_t]
    a, g = jnp.split(c, 2, axis=-1)
    y = (jax.nn.silu(a) * g) @ w_down
    return y, u[:, u.shape[1] - (CONV_W - 1):]


def layer(x, pos, ckv_past, kr_past, bk_past, bv_past, ck_past, cv_past, conv_past,
          g_attn, w_in, g_q, w_uq, g_kv, w_uk, w_uv, rel_bias, g_heads, w_out,
          g_ffn, w_up, w_conv, b_conv, w_down, prompt):
    n_b, n_t, _ = x.shape
    h = rmsnorm(x, g_attn)
    cq, ckv_raw, kr_raw, qkv_b, qkv_c = jnp.split(h @ w_in, IN_SPLITS, axis=-1)

    q_a = (rmsnorm(cq, g_q) @ w_uq).reshape(n_b, n_t, A_HEADS, A_NOPE + A_ROPE)
    q_a = jnp.concatenate([q_a[..., :A_NOPE], rope(q_a[..., A_NOPE:], pos)], axis=-1)
    ckv = rmsnorm(ckv_raw, g_kv)
    krope = rope(kr_raw, pos)
    ckv_all = jnp.concatenate([ckv_past, ckv], axis=1)
    kr_all = jnp.concatenate([kr_past, krope], axis=1)
    n_past = ckv_past.shape[1]
    n_k = ckv_all.shape[1]
    ka_pos = key_positions(pos, n_past)
    k_a = jnp.concatenate([(ckv_all @ w_uk).reshape(n_b, n_k, A_HEADS, A_NOPE),
                           jnp.broadcast_to(kr_all[:, :, None], (n_b, n_k, A_HEADS, A_ROPE))], axis=-1)
    v_a = (ckv_all @ w_uv).reshape(n_b, n_k, A_HEADS, A_VDIM)
    out_a = sweep_queries(lambda qs, qp, e: mla_attend(qs[0], qp, k_a[:, :e], v_a[:, :e], ka_pos[:e]),
                          (q_a,), pos, n_past)

    qkv_b = qkv_b.reshape(n_b, n_t, 3, B_HEADS, B_DIM)
    q_b, k_b, v_b = qkv_b[:, :, 0], qkv_b[:, :, 1], qkv_b[:, :, 2]
    if prompt:
        out_b = band_prompt(q_b, k_b, v_b, rel_bias)
        rows = min(B_PAST, n_t)
        bk_new, bv_new = k_b[:, n_t - rows:], v_b[:, n_t - rows:]
    else:
        out_b = band_sample(q_b, k_b, v_b, bk_past, bv_past, pos, rel_bias)
        bk_new, bv_new = k_b, v_b

    qkv_c = qkv_c.reshape(n_b, n_t, 3, C_HEADS, C_DIM)
    q_c, k_c, v_c = qkv_c[:, :, 0], qkv_c[:, :, 1], qkv_c[:, :, 2]
    k_c_all = jnp.concatenate([ck_past, k_c], axis=1)
    v_c_all = jnp.concatenate([cv_past, v_c], axis=1)
    nc_past = ck_past.shape[1]
    kc_pos = key_positions(pos, nc_past)
    out_c = sweep_queries(lambda qs, qp, e: sb_attend(qs[0], qp, k_c_all[:, :e], v_c_all[:, :e], kc_pos[:e]),
                          (q_c,), pos, nc_past)

    heads = jnp.concatenate([out_a, out_b, out_c], axis=2)
    mixed = rmsnorm(heads, g_heads.reshape(N_OUT_HEADS, HEAD_DIM_OUT)).reshape(n_b, n_t, MIX_WIDTH)
    x = x + mixed @ w_out
    y, conv_new = conv_ffn(rmsnorm(x, g_ffn), conv_past, w_up, w_conv, b_conv, w_down)
    x = x + y
    return x, ckv, krope, bk_new, bv_new, k_c, v_c, conv_new


def setup_inputs(seed: int = 0) -> dict:
    key = jax.random.key(seed)
    ks = jax.random.split(key, 32)
    f32 = jnp.float32

    def nrm(k, shape, scale=1.0):
        return scale * jax.random.normal(k, shape, f32)

    def gain(k, shape):
        return 1.0 + 0.02 * jax.random.normal(k, shape, f32)

    r_b = min(B_PAST, PAST_LEN)
    return {
        'x_prompt': nrm(ks[0], (BATCH, SEQ, D_MODEL)),
        'x_sample': nrm(ks[1], (DEC_BATCH, DEC_SEQ, D_MODEL)),
        'cache_a_ckv': nrm(ks[2], (DEPTH, DEC_BATCH, PAST_LEN, KV_LORA)),
        'cache_a_krope': nrm(ks[3], (DEPTH, DEC_BATCH, PAST_LEN, A_ROPE)),
        'cache_b_k': nrm(ks[4], (DEPTH, DEC_BATCH, r_b, B_HEADS, B_DIM)),
        'cache_b_v': nrm(ks[5], (DEPTH, DEC_BATCH, r_b, B_HEADS, B_DIM)),
        'cache_c_k': nrm(ks[6], (DEPTH, DEC_BATCH, PAST_LEN, C_HEADS, C_DIM)),
        'cache_c_v': nrm(ks[7], (DEPTH, DEC_BATCH, PAST_LEN, C_HEADS, C_DIM)),
        'state_conv': nrm(ks[8], (DEPTH, DEC_BATCH, CONV_W - 1, 2 * D_FF)),
        'g_attn': gain(ks[9], (DEPTH, D_MODEL)),
        'w_in': nrm(ks[10], (DEPTH, D_MODEL, IN_WIDTH), D_MODEL ** -0.5),
        'g_q': gain(ks[11], (DEPTH, Q_LORA)),
        'w_uq': nrm(ks[12], (DEPTH, Q_LORA, A_HEADS * (A_NOPE + A_ROPE)), Q_LORA ** -0.5),
        'g_kv': gain(ks[13], (DEPTH, KV_LORA)),
        'w_uk': nrm(ks[14], (DEPTH, KV_LORA, A_HEADS * A_NOPE), KV_LORA ** -0.5),
        'w_uv': nrm(ks[15], (DEPTH, KV_LORA, A_HEADS * A_VDIM), KV_LORA ** -0.5),
        'rel_bias': nrm(ks[16], (DEPTH, B_HEADS, 2 * B_REL_CLIP + 1), 0.2),
        'g_heads': gain(ks[17], (DEPTH, MIX_WIDTH)),
        'w_out': nrm(ks[18], (DEPTH, MIX_WIDTH, D_MODEL), MIX_WIDTH ** -0.5),
        'g_ffn': gain(ks[19], (DEPTH, D_MODEL)),
        'w_up': nrm(ks[20], (DEPTH, D_MODEL, 2 * D_FF), D_MODEL ** -0.5),
        'w_conv': nrm(ks[21], (DEPTH, CONV_W, 2 * D_FF), CONV_W ** -0.5),
        'b_conv': nrm(ks[22], (DEPTH, 2 * D_FF), 0.01),
        'w_down': nrm(ks[23], (DEPTH, D_FF, D_MODEL), D_FF ** -0.5),
        'g_final': gain(ks[24], (D_MODEL,)),
    }


def reference(x_prompt, x_sample, cache_a_ckv, cache_a_krope, cache_b_k, cache_b_v, cache_c_k, cache_c_v,
              state_conv, g_attn, w_in, g_q, w_uq, g_kv, w_uk, w_uv, rel_bias, g_heads, w_out,
              g_ffn, w_up, w_conv, b_conv, w_down, g_final):
    n_bp, n_tp, _ = x_prompt.shape
    n_ts = x_sample.shape[1]
    past_len = cache_c_k.shape[2]
    dt = x_prompt.dtype
    pos_p = jnp.arange(n_tp, dtype=jnp.int32)
    pos_s = past_len + jnp.arange(n_ts, dtype=jnp.int32)
    empty_ckv = jnp.zeros((n_bp, 0, KV_LORA), dt)
    empty_kr = jnp.zeros((n_bp, 0, A_ROPE), dt)
    empty_c = jnp.zeros((n_bp, 0, C_HEADS, C_DIM), dt)
    conv_zero = jnp.zeros((n_bp, CONV_W - 1, 2 * D_FF), dt)

    xp, xs = x_prompt, x_sample
    p_layers, s_layers = [], []
    for l in range(DEPTH):
        weights = (g_attn[l], w_in[l], g_q[l], w_uq[l], g_kv[l], w_uk[l], w_uv[l], rel_bias[l], g_heads[l],
                   w_out[l], g_ffn[l], w_up[l], w_conv[l], b_conv[l], w_down[l])
        xp, *p_st = layer(xp, pos_p, empty_ckv, empty_kr, None, None, empty_c, empty_c, conv_zero,
                          *weights, prompt=True)
        xs, *s_st = layer(xs, pos_s, cache_a_ckv[l], cache_a_krope[l], cache_b_k[l], cache_b_v[l],
                          cache_c_k[l], cache_c_v[l], state_conv[l], *weights, prompt=False)
        p_layers.append(p_st)
        s_layers.append(s_st)

    y_prompt = rmsnorm(xp, g_final)
    y_sample = rmsnorm(xs, g_final)
    p_a_ckv, p_a_krope, p_b_k, p_b_v, p_c_k, p_c_v, p_conv = [jnp.stack(t) for t in zip(*p_layers)]
    s_a_ckv, s_a_krope, s_b_k, s_b_v, s_c_k, s_c_v, s_conv = [jnp.stack(t) for t in zip(*s_layers)]
    return (y_prompt, y_sample, p_a_ckv, p_a_krope, p_b_k, p_b_v, p_c_k, p_c_v, p_conv,
            s_a_ckv, s_a_krope, s_b_k, s_b_v, s_c_k, s_c_v, s_conv)
```

```cpp
#include <hip/hip_runtime.h>
#include <cstdio>
#include <cstdint>

#define LAS __attribute__((address_space(3)))
#define GAS __attribute__((address_space(1)))
typedef unsigned short bf16_t;
typedef short bf16x8 __attribute__((ext_vector_type(8)));
typedef short s16x4 __attribute__((ext_vector_type(4)));
typedef float f32x2 __attribute__((ext_vector_type(2)));
typedef float f32x4 __attribute__((ext_vector_type(4)));
typedef float f32x16 __attribute__((ext_vector_type(16)));
typedef unsigned u32x2 __attribute__((ext_vector_type(2)));
typedef unsigned u32x4 __attribute__((ext_vector_type(4)));
typedef __bf16 bf16x2_t __attribute__((ext_vector_type(2)));

constexpr int DM = 2048, NB = 2, SEQ = 16384, DEPTH = 4, SB = 8, SS = 64, PAST = 1024;
constexpr int MP = NB * SEQ, MS = SB * SS, MT = MP + MS;
constexpr int CSTR = PAST + SS, BSTR = 512 + SS;
constexpr int MC = MP + SB * CSTR, MBB = MP + SB * BSTR;
constexpr int NIN = 4352, DFF = 5632, NUP = 2 * DFF, NMIX = 1536;
constexpr float EPS = 1e-6f;
constexpr float LOG2E = 1.4426950408889634f;
constexpr float SC_A = 0.07216878364870322f * LOG2E;
constexpr float SC_BC = 0.08838834764831845f * LOG2E;

constexpr size_t O_YP = 0, O_YS = O_YP + (size_t)MP * DM, O_PACKV = O_YS + (size_t)MS * DM, O_PAKR = O_PACKV + (size_t)DEPTH * MP * 512,
    O_PBK = O_PAKR + (size_t)DEPTH * MP * 64, O_PBV = O_PBK + (size_t)DEPTH * NB * 512 * 512, O_PCK = O_PBV + (size_t)DEPTH * NB * 512 * 512,
    O_PCV = O_PCK + (size_t)DEPTH * MP * 512, O_PCONV = O_PCV + (size_t)DEPTH * MP * 512, O_SACKV = O_PCONV + (size_t)DEPTH * NB * 2 * NUP,
    O_SAKR = O_SACKV + (size_t)DEPTH * MS * 512, O_SBK = O_SAKR + (size_t)DEPTH * MS * 64, O_SBV = O_SBK + (size_t)DEPTH * MS * 512,
    O_SCK = O_SBV + (size_t)DEPTH * MS * 512, O_SCV = O_SCK + (size_t)DEPTH * MS * 512, O_SCONV = O_SCV + (size_t)DEPTH * MS * 512,
    O_END = O_SCONV + (size_t)DEPTH * SB * 2 * NUP;

constexpr size_t AL(size_t x) { return (x + 4095) & ~(size_t)4095; }
constexpr size_t WS_CTL = 0, CTL_ZERO_BYTES = 1u << 20;
constexpr size_t WS_ROPE = CTL_ZERO_BYTES;
constexpr size_t WS_SIDE = WS_ROPE + (size_t)SEQ * 32 * 8;
constexpr size_t WS_WIN = AL(WS_SIDE + (size_t)10 * 2 * NUP * 4);
constexpr size_t WS_WUQ = WS_WIN + (size_t)NIN * DM * 2;
constexpr size_t WS_WKV = WS_WUQ + (size_t)768 * 512 * 2;
constexpr size_t WS_WOUT = WS_WKV + (size_t)1024 * 512 * 2;
constexpr size_t WS_WUP = WS_WOUT + (size_t)DM * NMIX * 2;
constexpr size_t WS_WDN = WS_WUP + (size_t)NUP * DM * 2;
constexpr size_t WS_HG = WS_WDN + (size_t)DM * DFF * 2;
constexpr size_t WS_H = WS_HG + 16384;
constexpr size_t WS_ATT = AL(WS_H + (size_t)(MT + 512) * DM * 2);
constexpr size_t WS_CQ = WS_ATT;
constexpr size_t WS_QA = WS_CQ + (size_t)MT * 512 * 2;
constexpr size_t WS_CKV = WS_QA + (size_t)MT * 768 * 2;
constexpr size_t WS_KR = WS_CKV + (size_t)MC * 512 * 2;
constexpr size_t WS_KA = WS_KR + (size_t)MC * 64 * 2;
constexpr size_t WS_VA = WS_KA + (size_t)MC * 512 * 2;
constexpr size_t WS_QB = WS_VA + (size_t)MC * 512 * 2;
constexpr size_t WS_KB = WS_QB + (size_t)MT * 512 * 2;
constexpr size_t WS_VB = WS_KB + (size_t)MBB * 512 * 2;
constexpr size_t WS_QC = WS_VB + (size_t)MBB * 512 * 2;
constexpr size_t WS_KC = WS_QC + (size_t)MT * 512 * 2;
constexpr size_t WS_VC = WS_KC + (size_t)MC * 512 * 2;
constexpr size_t WS_HEADS = WS_VC + (size_t)MC * 512 * 2;
constexpr size_t WS_ATT_END = WS_HEADS + (size_t)MT * NMIX * 2;
constexpr size_t WS_ACT = WS_ATT;
constexpr size_t WS_PART = AL((WS_ATT_END > WS_ACT + (size_t)MT * DFF * 2 ? WS_ATT_END : WS_ACT + (size_t)MT * DFF * 2) + 65536);
constexpr int NS_DOWN = 11, NS_OUT = 6;
constexpr size_t WS_SSQ = AL(WS_PART + (size_t)NS_DOWN * MS * DM * 4);
constexpr size_t SSQ_BYTES = (size_t)(DEPTH + 1) * 2 * MT * 4;
constexpr size_t WS_SSP = AL(WS_SSQ + SSQ_BYTES);
constexpr size_t WS_END = AL(WS_SSP + (size_t)MT * 32 * 4) + 65536;
static_assert(WS_END < (size_t)1000 * 1000 * 1000, "workspace map");

constexpr int CW_BAR = 4096;
constexpr int CW_Q = 16384;
constexpr int CW_KMAX = 65536;
constexpr int KMAXL_OFF = 131072 + 2048;
constexpr int XCH_OFF = 131072 + 4096;

constexpr int RING_BYTES = 131072, MISC_OFF = RING_BYTES + 320, LDS_BYTES = 147456;

__device__ __forceinline__ unsigned cvtpk(float lo, float hi) { f32x2 v = {lo, hi}; bf16x2_t b = __builtin_convertvector(v, bf16x2_t); return __builtin_bit_cast(unsigned, b); }
__device__ __forceinline__ float bf_lo(unsigned u) { return __uint_as_float(u << 16); }
__device__ __forceinline__ float bf_hi(unsigned u) { return __uint_as_float(u & 0xffff0000u); }
__device__ __forceinline__ float wave_sum(float v) {
#pragma unroll
    for (int o = 1; o < 64; o <<= 1) v += __shfl_xor(v, o);
    return v;
}
#define LDS_WAIT() asm volatile("s_waitcnt lgkmcnt(0)" ::: "memory")
#define VM_WAIT() asm volatile("s_waitcnt vmcnt(0)" ::: "memory")
__device__ __forceinline__ int fresh_tid() { int t = threadIdx.x; asm volatile("" : "+v"(t)); return t; }
namespace pg8 {
constexpr int BM = 256, BK = 64, HALF = 128, HTB = HALF * BK * 2, STAGE_BYTES = 8 * HTB, NXCD = 8, WGM = 4;
__host__ __device__ __forceinline__ int lds_byte(int r, int c) { const int st = (r >> 4) * 2 + (c >> 5), rr = r & 15, cc = c & 31, ob = rr * 64 + cc * 2; return st * 1024 + (ob ^ (((ob >> 9) & 1) << 5)); }
__host__ __device__ __forceinline__ void stage_rc(int b, int& R, int& C) { const int st = b / 1024, sb = b % 1024, swz = sb ^ (((sb >> 9) & 1) << 5); R = (st >> 1) * 16 + swz / 64; C = (st & 1) * 32 + (swz % 64) / 2; }
__host__ __device__ __forceinline__ int perm32(int rho) { const int n = rho >> 4, i = rho & 15; return 8 * (i >> 2) + 4 * n + (i & 3); }

struct Unit { int pm, pn, k0, nk; };
struct Gemm { const bf16_t* A; const bf16_t* Bt; int K; };

struct StaticOrder {
    int nM, nN, nwg, G, c, nkt, wgm;
    __device__ void init(int nM_, int nN_, int G_, int c_, int nkt_, int wgm_ = WGM) { nM = nM_; nN = nN_; nwg = nM * nN; G = G_; c = c_; nkt = nkt_; wgm = wgm_; }
    __device__ void map(int wgid, Unit& u) const {
        { const int q = nwg / NXCD, r = nwg % NXCD, xcd = wgid % NXCD, off = wgid / NXCD; wgid = (xcd < r ? xcd * (q + 1) : r * (q + 1) + (xcd - r) * q) + off; }
        const int nig = wgm * nN, gid = wgid / nig, fm = gid * wgm, gsz = (nM - fm) < wgm ? (nM - fm) : wgm;
        u.pm = fm + ((wgid % nig) % gsz); u.pn = (wgid % nig) / gsz; u.k0 = 0; u.nk = nkt;
    }
    __device__ bool next(int i, Unit& u) const { const long L = (long)i * G + c; if (L >= nwg) return false; map((int)L, u); return true; }
};
struct TailOrder {
    StaticOrder so; int nMt, NS, nks;
    __device__ void init(int nMf, int nMt_, int nN, int G, int c, int nkt, int NS_, int wgm_ = WGM) { so.init(nMf, nN, G, c, nkt, wgm_); nMt = nMt_; NS = NS_; nks = nkt / NS_; }
    __device__ bool next(int i, Unit& u) const {
        const long L = (long)i * so.G + so.c;
        if (L < so.nwg) { so.map((int)L, u); return true; }
        const int r = (int)(L - so.nwg); if (r >= nMt * so.nN * NS) return false;
        const int s = r % NS, t = r / NS; u.pn = t % so.nN; u.pm = so.nM + t / so.nN; u.k0 = s * nks; u.nk = nks; return true;
    }
};

template <class Epi, class Sched, int AMODE>
__device__ __forceinline__ void gemm_phase(LAS unsigned char* lds, const Gemm g, const Sched& S, const Epi& E) {
    const int tid = fresh_tid(), wid = __builtin_amdgcn_readfirstlane(tid >> 6), lane = tid & 63, wr = wid >> 2, wc = wid & 3, fr = lane & 15, fq = lane >> 4;
    const int K = g.K;
    unsigned voffA[2], voffB[2];
#pragma unroll
    for (int i = 0; i < 2; ++i) { int R, C; stage_rc(tid * 16 + i * 8192, R, C); const int Rb = Epi::PERM ? ((R & ~31) + perm32(R & 31)) : R; const int Ra = (AMODE == 1) ? (62 * (R >> 6) + (R & 63)) : R;
        voffA[i] = (unsigned)(Ra * K + C) * 2u; voffB[i] = (unsigned)(Rb * K + C) * 2u; }
    const size_t kstep = (size_t)(BK * 2);
    const size_t hstepB = (size_t)HALF * K * 2, tstepB = 2 * hstepB;
    const size_t hstepA = (size_t)(AMODE == 1 ? 124 : 128) * K * 2, tstepA = (AMODE == 2) ? (size_t)254 * K * 2 : 2 * hstepA;
    const unsigned ldsw = (unsigned)wid * 1024u;
    const int aoff = lds_byte(wr * 64 + fr, fq * 8), boff = lds_byte(wc * 32 + fr, fq * 8);
#define PG8_SA(b, h) (((b) * 2 + (h)) * HTB)
#define PG8_SB(b, h) ((4 + (b) * 2 + (h)) * HTB)
#define PG8_STAGE(bufoff, gbase, voff) do { _Pragma("unroll") for (int _i = 0; _i < 2; ++_i) \
        __builtin_amdgcn_global_load_lds((const unsigned*)((const char*)(gbase) + (voff)[_i]), (LAS unsigned*)(lds + (bufoff) + ldsw + _i * 8192), 16, 0, 0); } while (0)
#define PG8_LDA(dst, b, h) do { _Pragma("unroll") for (int m = 0; m < 4; ++m) _Pragma("unroll") for (int k = 0; k < 2; ++k) dst[m][k] = *(const LAS bf16x8*)(lds + PG8_SA(b, h) + aoff + m * 2048 + k * 1024); } while (0)
#define PG8_LDB(dst, b, h) do { _Pragma("unroll") for (int n = 0; n < 2; ++n) _Pragma("unroll") for (int k = 0; k < 2; ++k) dst[n][k] = *(const LAS bf16x8*)(lds + PG8_SB(b, h) + boff + n * 2048 + k * 1024); } while (0)
#define PG8_MMA(ai, bj, At, Bt) do { __builtin_amdgcn_s_setprio(1); _Pragma("unroll") for (int m = 0; m < 4; ++m) _Pragma("unroll") for (int n = 0; n < 2; ++n) _Pragma("unroll") for (int k = 0; k < 2; ++k) \
        acc[ai][bj][m][n] = __builtin_amdgcn_mfma_f32_16x16x32_bf16(Bt[n][k], At[m][k], acc[ai][bj][m][n], 0, 0, 0); __builtin_amdgcn_s_setprio(0); } while (0)
#define PG8_WAIT_V(n) asm volatile("s_waitcnt vmcnt(" #n ")" ::: "memory")
#define PG8_WAIT_L(n) asm volatile("s_waitcnt lgkmcnt(" #n ")" ::: "memory")
#define PG8_BAR __builtin_amdgcn_s_barrier()
#define PG8_SCHED __builtin_amdgcn_sched_barrier(0)
    Unit cur, nxt; int ui = 0;
    if (!S.next(0, cur)) return;
    f32x4 acc[2][2][4][2];
#pragma unroll
    for (int a = 0; a < 2; ++a)
#pragma unroll
        for (int b = 0; b < 2; ++b)
#pragma unroll
            for (int m = 0; m < 4; ++m)
#pragma unroll
                for (int n = 0; n < 2; ++n) acc[a][b][m][n] = (f32x4){0.f, 0.f, 0.f, 0.f};
    bf16x8 At[4][2], B0[2][2], B1[2][2];
    const char* cA = (const char*)g.A + (size_t)cur.pm * tstepA + (size_t)cur.k0 * kstep; const char* cB = (const char*)g.Bt + (size_t)cur.pn * tstepB + (size_t)cur.k0 * kstep;
    PG8_STAGE(PG8_SB(0, 0), cB, voffB); PG8_STAGE(PG8_SB(0, 1), cB + hstepB, voffB); PG8_STAGE(PG8_SA(0, 0), cA, voffA); PG8_STAGE(PG8_SA(0, 1), cA + hstepA, voffA);
    if (wr == 1) PG8_BAR;
    PG8_WAIT_V(2); PG8_BAR;
    PG8_STAGE(PG8_SB(1, 0), cB + kstep, voffB); PG8_STAGE(PG8_SA(1, 0), cA + kstep, voffA); PG8_STAGE(PG8_SB(1, 1), cB + hstepB + kstep, voffB);
    PG8_WAIT_V(6); PG8_BAR;
    for (;;) {
        const bool has_next = S.next(ui + 1, nxt);
        const char* nA = has_next ? (const char*)g.A + (size_t)nxt.pm * tstepA + (size_t)nxt.k0 * kstep : cA; const char* nB = has_next ? (const char*)g.Bt + (size_t)nxt.pn * tstepB + (size_t)nxt.k0 * kstep : cB;
        const int nt = cur.nk;
        for (int t = 0; t < nt; t += 2) {
            const bool last = (t == nt - 2);
            const char* a1 = cA + (size_t)(t + 1) * kstep;
            const char* a2 = last ? nA : cA + (size_t)(t + 2) * kstep; const char* b2 = last ? nB : cB + (size_t)(t + 2) * kstep;
            const char* a3 = a2 + kstep; const char* b3 = b2 + kstep;
            PG8_LDB(B0, 0, 0); PG8_LDB(B1, 0, 1); PG8_SCHED; PG8_LDA(At, 0, 0); PG8_STAGE(PG8_SA(1, 1), a1 + hstepA, voffA);
            PG8_WAIT_V(8); PG8_WAIT_L(0); PG8_BAR; PG8_MMA(0, 0, At, B0); PG8_MMA(0, 1, At, B1); PG8_BAR; PG8_SCHED;
            PG8_LDA(At, 0, 1); PG8_STAGE(PG8_SB(0, 0), b2, voffB); PG8_STAGE(PG8_SB(0, 1), b2 + hstepB, voffB); PG8_STAGE(PG8_SA(0, 0), a2, voffA);
            PG8_WAIT_V(8); PG8_WAIT_L(0); PG8_BAR; PG8_MMA(1, 0, At, B0); PG8_MMA(1, 1, At, B1); PG8_BAR; PG8_SCHED;
            PG8_LDB(B0, 1, 0); PG8_LDB(B1, 1, 1); PG8_SCHED; PG8_LDA(At, 1, 0); PG8_STAGE(PG8_SA(0, 1), a2 + hstepA, voffA);
            PG8_WAIT_V(8); PG8_WAIT_L(0); PG8_BAR; PG8_MMA(0, 0, At, B0); PG8_MMA(0, 1, At, B1); PG8_BAR; PG8_SCHED;
            PG8_LDA(At, 1, 1); PG8_STAGE(PG8_SB(1, 0), b3, voffB); PG8_STAGE(PG8_SB(1, 1), b3 + hstepB, voffB); PG8_STAGE(PG8_SA(1, 0), a3, voffA);
            PG8_WAIT_V(8); PG8_WAIT_L(0); PG8_BAR; PG8_MMA(1, 0, At, B0); PG8_MMA(1, 1, At, B1); PG8_BAR; PG8_SCHED;
        }
        if (wr == 0) PG8_BAR;
        E(acc, cur, wr, wc, fr, fq);
        if (!has_next) break;
#pragma unroll
        for (int a = 0; a < 2; ++a)
#pragma unroll
            for (int b = 0; b < 2; ++b)
#pragma unroll
                for (int m = 0; m < 4; ++m)
#pragma unroll
                    for (int n = 0; n < 2; ++n) acc[a][b][m][n] = (f32x4){0.f, 0.f, 0.f, 0.f};
        cur = nxt; cA = nA; cB = nB; ++ui;
        if (wr == 1) PG8_BAR;
    }
    PG8_WAIT_V(0);
    PG8_BAR;
#undef PG8_SA
#undef PG8_SB
#undef PG8_STAGE
#undef PG8_LDA
#undef PG8_LDB
#undef PG8_MMA
#undef PG8_WAIT_V
#undef PG8_WAIT_L
#undef PG8_BAR
#undef PG8_SCHED
}
}
namespace pg8 {
template <int CTRL> __device__ __forceinline__ float dpp_f(float x) { return __builtin_bit_cast(float, __builtin_amdgcn_update_dpp(0, __builtin_bit_cast(int, x), CTRL, 0xf, 0xf, true)); }
__device__ __forceinline__ int map_c(int m) { if (m < MP) return m; const int ms = m - MP; return MP + (ms >> 6) * CSTR + PAST + (ms & 63); }
__device__ __forceinline__ int map_b(int m) { if (m < MP) return m; const int ms = m - MP; return MP + (ms >> 6) * BSTR + 512 + (ms & 63); }

struct EpiIn {
    static constexpr bool PERM = true;
    unsigned char* ws; float* out; int l; const float* ssq;
    __device__ __forceinline__ void operator()(const f32x4 (&acc)[2][2][4][2], const Unit& u, int wr, int wc, int fr, int fq) const {
        const int pn = u.pn; const bool smp = u.pm >= (MP / 256);
        size_t doff = WS_CQ, fbase = 0; int pitch = 512, sub = pn & 1, rowmode = 0, fkind = 0; float sc = 1.f;
        if (pn < 2) { doff = WS_CQ; }
        else if (pn < 4) { doff = WS_CKV; rowmode = 1; }
        else if (pn < 10) { const int w = (pn - 4) >> 1; if (w == 0) { doff = WS_QB; sc = SC_BC; } else { doff = (w == 1) ? WS_KB : WS_VB; rowmode = 2; fkind = 1;
                fbase = smp ? (w == 1 ? O_SBK : O_SBV) + (size_t)l * MS * 512 : (w == 1 ? O_PBK : O_PBV) + (size_t)l * NB * 512 * 512; } }
        else if (pn < 16) { const int w = (pn - 10) >> 1; if (w == 0) { doff = WS_QC; sc = SC_BC; } else { doff = (w == 1) ? WS_KC : WS_VC; rowmode = 1; fkind = 2;
                fbase = smp ? (w == 1 ? O_SCK : O_SCV) + (size_t)l * MS * 512 : (w == 1 ? O_PCK : O_PCV) + (size_t)l * MP * 512; } }
        else { doff = WS_KR; pitch = 64; sub = 0; rowmode = 1; }
        bf16_t* dst = (bf16_t*)(ws + doff); float* fo = out + fbase;
        const int lc0 = 256 * sub + 32 * wc + 8 * fq;
#pragma unroll
        for (int ai = 0; ai < 2; ++ai)
#pragma unroll
            for (int m = 0; m < 4; ++m) {
                const int mrow = u.pm * 256 + ai * 128 + wr * 64 + m * 16 + fr;
                const int drow = rowmode == 0 ? mrow : (rowmode == 1 ? map_c(mrow) : map_b(mrow));
                const float rs = 1.0f / sqrtf(ssq[mrow] * (1.f / DM) + EPS), scr = sc * rs;
                long foff = -1;
                if (fkind) {
                    if (smp) foff = (long)(mrow - MP) * 512;
                    else if (fkind == 2) foff = (long)mrow * 512;
                    else { const int t = mrow & (SEQ - 1), b = mrow >> 14; if (t >= SEQ - 512) foff = (long)(b * 512 + (t - (SEQ - 512))) * 512; }
                }
#pragma unroll
                for (int bj = 0; bj < 2; ++bj) {
                    const int lc = lc0 + bj * 128;
                    if (pn == 16 && lc >= 64) continue;
                    const f32x4 v0 = acc[ai][bj][m][0], v1 = acc[ai][bj][m][1];
                    u32x4 w; w.x = cvtpk(v0[0] * scr, v0[1] * scr); w.y = cvtpk(v0[2] * scr, v0[3] * scr); w.z = cvtpk(v1[0] * scr, v1[1] * scr); w.w = cvtpk(v1[2] * scr, v1[3] * scr);
                    *(u32x4*)(dst + (size_t)drow * pitch + lc) = w;
                    if (foff >= 0) { float* fp = fo + foff + lc; __builtin_nontemporal_store(v0 * rs, (f32x4*)fp); __builtin_nontemporal_store(v1 * rs, (f32x4*)(fp + 4)); }
                }
            }
    }
};

struct EpiQ {
    static constexpr bool PERM = true;
    bf16_t* QA; const f32x2* rope;
    __device__ __forceinline__ void operator()(const f32x4 (&acc)[2][2][4][2], const Unit& u, int wr, int wc, int fr, int fq) const {
#pragma unroll
        for (int bj = 0; bj < 2; ++bj) {
            const int c0 = 256 * u.pn + 128 * bj + 32 * wc + 8 * fq, j = c0 % 192; const bool isrope = j >= 128; const int i0 = (j - 128) >> 1;
#pragma unroll
            for (int ai = 0; ai < 2; ++ai)
#pragma unroll
                for (int m = 0; m < 4; ++m) {
                    const int mrow = u.pm * 256 + ai * 128 + wr * 64 + m * 16 + fr;
                    f32x4 v0 = acc[ai][bj][m][0], v1 = acc[ai][bj][m][1];
                    if (isrope) {
                        const int pos = mrow < MP ? (mrow & (SEQ - 1)) : PAST + ((mrow - MP) & 63);
                        const f32x4* cs = (const f32x4*)(rope + (size_t)pos * 32 + i0);
                        const f32x4 ca = cs[0], cb = cs[1];
                        f32x4 r0, r1;
                        r0[0] = v0[0] * ca[0] - v0[1] * ca[1]; r0[1] = v0[0] * ca[1] + v0[1] * ca[0];
                        r0[2] = v0[2] * ca[2] - v0[3] * ca[3]; r0[3] = v0[2] * ca[3] + v0[3] * ca[2];
                        r1[0] = v1[0] * cb[0] - v1[1] * cb[1]; r1[1] = v1[0] * cb[1] + v1[1] * cb[0];
                        r1[2] = v1[2] * cb[2] - v1[3] * cb[3]; r1[3] = v1[2] * cb[3] + v1[3] * cb[2];
                        v0 = r0; v1 = r1;
                    }
                    u32x4 w; w.x = cvtpk(v0[0] * SC_A, v0[1] * SC_A); w.y = cvtpk(v0[2] * SC_A, v0[3] * SC_A); w.z = cvtpk(v1[0] * SC_A, v1[1] * SC_A); w.w = cvtpk(v1[2] * SC_A, v1[3] * SC_A);
                    *(u32x4*)(QA + (size_t)mrow * 768 + c0) = w;
                }
        }
    }
};

struct EpiKV {
    static constexpr bool PERM = true;
    bf16_t *KA, *VA;
    __device__ __forceinline__ void operator()(const f32x4 (&acc)[2][2][4][2], const Unit& u, int wr, int wc, int fr, int fq) const {
        bf16_t* dst = (u.pn < 2) ? KA : VA; const int lc0 = 256 * (u.pn & 1) + 32 * wc + 8 * fq;
#pragma unroll
        for (int ai = 0; ai < 2; ++ai)
#pragma unroll
            for (int m = 0; m < 4; ++m) {
                const int row = u.pm * 256 + ai * 128 + wr * 64 + m * 16 + fr;
#pragma unroll
                for (int bj = 0; bj < 2; ++bj) {
                    const f32x4 v0 = acc[ai][bj][m][0], v1 = acc[ai][bj][m][1];
                    u32x4 w; w.x = cvtpk(v0[0], v0[1]); w.y = cvtpk(v0[2], v0[3]); w.z = cvtpk(v1[0], v1[1]); w.w = cvtpk(v1[2], v1[3]);
                    *(u32x4*)(dst + (size_t)row * 512 + lc0 + bj * 128) = w;
                }
            }
    }
};

struct EpiRes {
    static constexpr bool PERM = true;
    bf16_t* XB; float* part; int nkt; float* ssp;
    __device__ __forceinline__ void operator()(const f32x4 (&acc)[2][2][4][2], const Unit& u, int wr, int wc, int fr, int fq) const {
        const int col0 = u.pn * 256 + wc * 32 + 8 * fq;
        const bool split = u.nk != nkt;
        const int slice = split ? u.k0 / u.nk : 0;
#pragma unroll
        for (int ai = 0; ai < 2; ++ai)
#pragma unroll
            for (int m = 0; m < 4; ++m) {
                const int row = u.pm * 256 + ai * 128 + wr * 64 + m * 16 + fr;
                if (split) {
                    float* op = part + ((size_t)slice * MS + (size_t)(row - MP)) * DM + col0;
#pragma unroll
                    for (int bj = 0; bj < 2; ++bj) { *(f32x4*)(op + bj * 128) = acc[ai][bj][m][0]; *(f32x4*)(op + bj * 128 + 4) = acc[ai][bj][m][1]; }
                } else {
                    bf16_t* xp = XB + (size_t)row * DM + col0;
                    float s = 0.f;
#pragma unroll
                    for (int bj = 0; bj < 2; ++bj) {
                        const u32x4 b = *(const u32x4*)(xp + bj * 128);
                        const f32x4 a0 = acc[ai][bj][m][0], a1 = acc[ai][bj][m][1];
                        const float x0 = bf_lo(b.x) + a0[0], x1 = bf_hi(b.x) + a0[1], x2 = bf_lo(b.y) + a0[2], x3 = bf_hi(b.y) + a0[3], x4 = bf_lo(b.z) + a1[0], x5 = bf_hi(b.z) + a1[1], x6 = bf_lo(b.w) + a1[2], x7 = bf_hi(b.w) + a1[3];
                        s += (x0 * x0 + x1 * x1) + (x2 * x2 + x3 * x3) + (x4 * x4 + x5 * x5) + (x6 * x6 + x7 * x7);
                        u32x4 w; w.x = cvtpk(x0, x1); w.y = cvtpk(x2, x3); w.z = cvtpk(x4, x5); w.w = cvtpk(x6, x7);
                        *(u32x4*)(xp + bj * 128) = w;
                    }
                    s += __shfl_xor(s, 16); s += __shfl_xor(s, 32);
                    if (fq == 0) ssp[(size_t)row * 32 + u.pn * 4 + wc] = s;
                }
            }
    }
};

struct EpiUp {
    static constexpr bool PERM = true;
    bf16_t* ACT; const float *wconv, *bconv; float *side, *pconv, *sconv; const float* ssq; LAS unsigned char* xch;
    __device__ __forceinline__ void operator()(f32x4 (&acc)[2][2][4][2], const Unit& u, int wr_, int wc_, int fr_, int fq_) const {
        const bool rare_tile = u.pm == 0 || u.pm == 64 || u.pm >= 129;
        {
            int wr = wr_, wc = wc_, fr = fr_, fq = fq_; asm volatile("" : "+v"(fr), "+v"(fq)); asm volatile("" : "+s"(wr), "+s"(wc));
#pragma unroll
            for (int ai = 0; ai < 2; ++ai)
#pragma unroll
                for (int m = 0; m < 4; ++m) { int grow = 254 * u.pm + 128 * ai + 64 * wr + 16 * m + fr - 2; grow = grow < 0 ? 0 : (grow > MT - 1 ? MT - 1 : grow);
                    const float rs = 1.0f / sqrtf(ssq[grow] * (1.f / DM) + EPS);
#pragma unroll
                    for (int bj = 0; bj < 2; ++bj)
#pragma unroll
                        for (int n = 0; n < 2; ++n) acc[ai][bj][m][n] *= rs; }
            if (fr >= 14) {
#pragma unroll
                for (int ai = 0; ai < 2; ++ai)
#pragma unroll
                    for (int bj = 0; bj < 2; ++bj)
#pragma unroll
                        for (int n = 0; n < 2; ++n) *(LAS f32x4*)(xch + ((((((wc * 4 + 2 * ai + wr) * 2 + bj) * 2 + n) * 4 + fq) * 2) + (fr - 14)) * 16) = acc[ai][bj][3][n];
            }
            asm volatile("s_waitcnt lgkmcnt(0)" ::: "memory"); __builtin_amdgcn_s_barrier(); asm volatile("" ::: "memory");
            __builtin_amdgcn_sched_barrier(0);
        }
#pragma unroll
        for (int bj = 0; bj < 2; ++bj)
#pragma unroll
            for (int n = 0; n < 2; ++n) {
                int wr = wr_, wc = wc_, fr = fr_, fq = fq_;
                asm volatile("" : "+v"(fr), "+v"(fq));
                asm volatile("" : "+s"(wr), "+s"(wc));
                const int col = bj * DFF + 128 * u.pn + 32 * wc + 8 * fq + 4 * n;
                const f32x4 w0 = *(const f32x4*)(wconv + col), w1 = *(const f32x4*)(wconv + NUP + col), w2 = *(const f32x4*)(wconv + 2 * NUP + col), bb = *(const f32x4*)(bconv + col);
#pragma unroll
                for (int ai = 0; ai < 2; ++ai) {
                    const int gabove = 2 * ai + wr - 1;
                    const f32x4 xq = *(const LAS f32x4*)(xch + ((((((wc * 4 + (gabove < 0 ? 0 : gabove)) * 2 + bj) * 2 + n) * 4 + fq) * 2) + (fr & 1)) * 16);
#pragma unroll
                    for (int mm = 0; mm < 4; ++mm) {
                        const int m = 3 - mm;
                        const int R = 128 * ai + 64 * wr + 16 * m + fr, grow = 254 * u.pm + R - 2;
                        asm volatile("" : "+v"(acc[ai][bj][m][n]), "+v"(acc[ai][bj][m > 0 ? m - 1 : 0][n]));
                        const f32x4 v = acc[ai][bj][m][n], q = (m > 0) ? acc[ai][bj][m > 0 ? m - 1 : 0][n] : xq;
                        f32x4 p1, p2;
#pragma unroll
                        for (int c = 0; c < 4; ++c) { p1[c] = dpp_f<0x121>((fr == 15) ? q[c] : v[c]); p2[c] = dpp_f<0x122>((fr >= 14) ? q[c] : v[c]); }
                        if (rare_tile) {
                        const bool ok = R >= 2 && grow < MT, smp = grow >= MP;
                        const int g2 = smp ? grow - MP : grow, tseq = smp ? (g2 & 63) : (g2 & (SEQ - 1)), sq = smp ? 2 + (g2 >> 6) : (g2 >> 14), slen = smp ? SS : SEQ;
                        if (ok && (tseq < 2 || tseq >= slen - 2)) {
                            float* co = (tseq < 2) ? side + ((size_t)sq * 2 + tseq) * NUP : (smp ? sconv + ((size_t)(sq - 2) * 2 + (tseq - (SS - 2))) * NUP : pconv + ((size_t)sq * 2 + (tseq - (SEQ - 2))) * NUP);
                            *(f32x4*)(co + col) = v;
                        }
                        }
                        acc[ai][bj][m][n] = w0 * p2 + (w1 * p1 + (w2 * v + bb));
                        asm volatile("" : "+v"(acc[ai][bj][m][n]));
                    }
                }
                __builtin_amdgcn_sched_barrier(0);
            }
        int wr = wr_, wc = wc_, fr = fr_, fq = fq_;
        asm volatile("" : "+v"(fr), "+v"(fq));
        asm volatile("" : "+s"(wr), "+s"(wc));
        const int colA = 128 * u.pn + 32 * wc + 8 * fq;
#pragma unroll
        for (int ai = 0; ai < 2; ++ai)
#pragma unroll
            for (int m = 0; m < 4; ++m) {
                const int R = 128 * ai + 64 * wr + 16 * m + fr, grow = 254 * u.pm + R - 2;
                u32x4 w;
#pragma unroll
                for (int n = 0; n < 2; ++n) { const f32x4 ca = acc[ai][0][m][n], cg = acc[ai][1][m][n]; f32x4 r;
#pragma unroll
                    for (int c = 0; c < 4; ++c) r[c] = ca[c] * __builtin_amdgcn_rcpf(1.f + __expf(-ca[c])) * cg[c];
                    if (n == 0) { w.x = cvtpk(r[0], r[1]); w.y = cvtpk(r[2], r[3]); } else { w.z = cvtpk(r[0], r[1]); w.w = cvtpk(r[2], r[3]); } }
                if (R >= 2 && grow < MT) __builtin_nontemporal_store(w, (u32x4*)(ACT + (size_t)grow * DFF + colA));
            }
    }
};
}
#define XB_TMO      128
#define XB_XCNT(j)  (256  + 64 * (j))
#define XB_XSUB(j)  (1280 + 64 * (j))
#define XB_XGEN(j)  (2304 + 64 * (j))
#define XB_TOP      3328
#define XB_TOPGEN   3392
#define XCD_BAR_WORDS 3456
#define XB_SPIN_CAP (1u << 23)
__device__ __forceinline__ unsigned xb_ld(unsigned* p)              { return __hip_atomic_load(p, __ATOMIC_RELAXED, __HIP_MEMORY_SCOPE_AGENT); }
__device__ __forceinline__ unsigned xb_add(unsigned* p, unsigned v) { return __hip_atomic_fetch_add(p, v, __ATOMIC_RELAXED, __HIP_MEMORY_SCOPE_AGENT); }
__device__ __forceinline__ unsigned xb_xcc_id() { return (unsigned)__builtin_amdgcn_s_getreg((3 << 11) | 20) & 0xFu; }
#define XB_SPIN(cond, bar) do { unsigned _sp = 0; while (cond) { __builtin_amdgcn_s_sleep(1); \
    if ((++_sp & 255u) == 0u) { if (xb_ld(&(bar)[XB_TMO])) break; if (_sp > XB_SPIN_CAP) { atomicAdd(&(bar)[XB_TMO], 1u); break; } } } } while (0)
struct XcdBarrier { unsigned* bar; unsigned x; volatile LAS unsigned* st; };
__device__ __forceinline__ XcdBarrier xcd_barrier_post(unsigned* bar, volatile LAS unsigned* st) {
    XcdBarrier b; b.bar = bar; b.x = xb_xcc_id(); b.st = st;
    if (threadIdx.x == 0) (void)xb_add(&bar[XB_XCNT(b.x)], 1u);
    return b;
}
__device__ __forceinline__ void xcd_barrier_complete(unsigned* bar, unsigned x, unsigned& nloc, unsigned& nx) {
    const unsigned G = gridDim.x * gridDim.y * gridDim.z;
    unsigned sum, cnt, mine, sp = 0u;
    for (;;) {
        sum = 0u; cnt = 0u; mine = 0u;
#pragma unroll
        for (unsigned j = 0; j < 16; ++j) { const unsigned c = xb_ld(&bar[XB_XCNT(j)]); sum += c; cnt += (c > 0u) ? 1u : 0u; mine = (j == x) ? c : mine; }
        if (sum == G) break;
        __builtin_amdgcn_s_sleep(1);
        if ((++sp & 255u) == 0u) { if (xb_ld(&bar[XB_TMO])) break; if (sp > XB_SPIN_CAP) { atomicAdd(&bar[XB_TMO], 1u); break; } }
    }
    nloc = mine > 0u ? mine : 1u; nx = cnt > 0u ? cnt : 1u;
}
__device__ __forceinline__ void xcd_barrier(const XcdBarrier& b) {
    asm volatile("s_waitcnt vmcnt(0)" ::: "memory");
    __syncthreads();
    if (threadIdx.x == 0) {
        unsigned* bar = b.bar;
        __builtin_amdgcn_s_waitcnt(0);
        unsigned nloc = b.st[0], nx = b.st[1];
        if (nloc == 0u) { xcd_barrier_complete(bar, b.x, nloc, nx); b.st[0] = nloc; b.st[1] = nx; }
        const unsigned old = xb_add(&bar[XB_XSUB(b.x)], 1u);
        const unsigned gen = old / nloc;
        if (old + 1u == (gen + 1u) * nloc) {
            __builtin_amdgcn_fence(__ATOMIC_RELEASE, "agent");
            asm volatile("s_waitcnt vmcnt(0)" ::: "memory");
            const unsigned og = xb_add(&bar[XB_TOP], 1u);
            const unsigned tg = og / nx;
            if (og + 1u == (tg + 1u) * nx) xb_add(&bar[XB_TOPGEN], 1u);
            else XB_SPIN(xb_ld(&bar[XB_TOPGEN]) == tg, bar);
            __builtin_amdgcn_fence(__ATOMIC_ACQUIRE, "agent");
            xb_add(&bar[XB_XGEN(b.x)], 1u);
            asm volatile("s_waitcnt vmcnt(0)" ::: "memory");
        } else {
            XB_SPIN(xb_ld(&bar[XB_XGEN(b.x)]) == gen, bar);
            __builtin_amdgcn_fence(__ATOMIC_ACQUIRE, "agent");
            asm volatile("s_waitcnt vmcnt(0)" ::: "memory");
        }
    }
    __syncthreads();
}

struct MapIn  { __device__ __forceinline__ int operator()(int c) const { if (c < 1024) return c; if (c < 1088) { const int i = c - 1024; return 4096 + 2 * (i & 31) + (i >> 5); } return c - 64; } };
struct MapUq  { __device__ __forceinline__ int operator()(int c) const { const int hd = c / 192, j = c - hd * 192; if (j < 128) return c; const int i = j - 128; return hd * 192 + 128 + 2 * (i & 31) + (i >> 5); } };
struct MapOff { int off; __device__ __forceinline__ int operator()(int c) const { return c + off; } };
struct MapUp  { __device__ __forceinline__ int operator()(int c) const { if (c < DFF) return 256 * (c >> 7) + (c & 127); const int d = c - DFF; return 256 * (d >> 7) + 128 + (d & 127); } };

template <class MAP>
__device__ __forceinline__ void transpose_item(const float* W, int K, int N, bf16_t* WT, LAS float* scr, int item, int lane, MAP map, const float* gk = nullptr) {
    const int nblk = N / 32, kb = item / nblk, nb = item - kb * nblk, k0 = 64 * kb, n0 = 32 * nb;
#pragma unroll 8
    for (int i = 0; i < 32; ++i) { const int kk = 2 * i + (lane >> 5); scr[kk * 33 + (lane & 31)] = __builtin_nontemporal_load(W + (size_t)(k0 + kk) * N + n0 + (lane & 31)); }
    LDS_WAIT(); asm volatile("" ::: "memory");
    const int c = lane & 7;
    f32x4 g0 = {1.f, 1.f, 1.f, 1.f}, g1 = g0;
    if (gk) { g0 = *(const f32x4*)(gk + k0 + 8 * c); g1 = *(const f32x4*)(gk + k0 + 8 * c + 4); }
#pragma unroll
    for (int j = 0; j < 4; ++j) { const int n = (lane >> 3) + 8 * j; const LAS float* s = scr + (8 * c) * 33 + n;
        u32x4 o; o.x = cvtpk(s[0 * 33] * g0[0], s[1 * 33] * g0[1]); o.y = cvtpk(s[2 * 33] * g0[2], s[3 * 33] * g0[3]); o.z = cvtpk(s[4 * 33] * g1[0], s[5 * 33] * g1[1]); o.w = cvtpk(s[6 * 33] * g1[2], s[7 * 33] * g1[3]);
        *(u32x4*)(WT + (size_t)map(n0 + n) * K + k0 + 8 * c) = o; }
    LDS_WAIT(); asm volatile("" ::: "memory");
}

__device__ __forceinline__ void prep_row_f32(const float* xrow, bf16_t* orow, float* ssq, int lane) {
    const f32x4* xr = (const f32x4*)xrow + lane;
    f32x4 v[8]; float s = 0.f;
#pragma unroll
    for (int j = 0; j < 8; ++j) v[j] = __builtin_nontemporal_load(xr + 64 * j);
#pragma unroll
    for (int j = 0; j < 8; ++j) s += (v[j][0] * v[j][0] + v[j][1] * v[j][1]) + (v[j][2] * v[j][2] + v[j][3] * v[j][3]);
    s = wave_sum(s);
    if (lane == 0) *ssq = s;
    u32x2* o8 = (u32x2*)orow + lane;
#pragma unroll
    for (int j = 0; j < 8; ++j) { u32x2 w; w.x = cvtpk(v[j][0], v[j][1]); w.y = cvtpk(v[j][2], v[j][3]); o8[64 * j] = w; }
}
__device__ __forceinline__ void prep_row_bf(bf16_t* xrow, float* ssq, int lane, const float* part, int np, size_t pstride) {
    u32x2* xr = (u32x2*)xrow + lane;
    f32x4 v[8]; float s = 0.f;
#pragma unroll
    for (int j = 0; j < 8; ++j) { const u32x2 b = xr[64 * j]; v[j] = (f32x4){bf_lo(b.x), bf_hi(b.x), bf_lo(b.y), bf_hi(b.y)}; }
    for (int sl = 0; sl < np; ++sl) { const f32x4* pr = (const f32x4*)(part + (size_t)sl * pstride) + lane;
#pragma unroll
        for (int j = 0; j < 8; ++j) v[j] += pr[64 * j]; }
#pragma unroll
    for (int j = 0; j < 8; ++j) s += (v[j][0] * v[j][0] + v[j][1] * v[j][1]) + (v[j][2] * v[j][2] + v[j][3] * v[j][3]);
    s = wave_sum(s);
    if (lane == 0) *ssq = s;
#pragma unroll
    for (int j = 0; j < 8; ++j) { u32x2 w; w.x = cvtpk(v[j][0], v[j][1]); w.y = cvtpk(v[j][2], v[j][3]); xr[64 * j] = w; }
}
__device__ __forceinline__ void final_row(const bf16_t* xrow, float* yrow, const float* g, int lane, const float* ssq, const float* part = nullptr, int np = 0, size_t pstride = 0) {
    const u32x2* xr = (const u32x2*)xrow + lane; const f32x4* gr = (const f32x4*)g + lane; f32x4* yr = (f32x4*)yrow + lane;
    f32x4 v[8]; float s = 0.f;
#pragma unroll
    for (int j = 0; j < 8; ++j) { const u32x2 b = xr[64 * j]; v[j] = (f32x4){bf_lo(b.x), bf_hi(b.x), bf_lo(b.y), bf_hi(b.y)}; }
    for (int sl = 0; sl < np; ++sl) { const f32x4* pr = (const f32x4*)(part + (size_t)sl * pstride) + lane;
#pragma unroll
        for (int j = 0; j < 8; ++j) v[j] += pr[64 * j]; }
    if (ssq) s = wave_sum(lane < 32 ? ssq[lane] : 0.f);
    else {
#pragma unroll
        for (int j = 0; j < 8; ++j) s += (v[j][0] * v[j][0] + v[j][1] * v[j][1]) + (v[j][2] * v[j][2] + v[j][3] * v[j][3]);
        s = wave_sum(s);
    }
    const float rstd = 1.0f / sqrtf(s * (1.f / DM) + EPS);
#pragma unroll
    for (int j = 0; j < 8; ++j) { const f32x4 gg = gr[64 * j]; __builtin_nontemporal_store(v[j] * rstd * gg, yr + 64 * j); }
}
__device__ __forceinline__ void cvt_row512(const float* src, bf16_t* dst, int lane) {
    const f32x4 a = __builtin_nontemporal_load((const f32x4*)src + 2 * lane), b = __builtin_nontemporal_load((const f32x4*)src + 2 * lane + 1);
    u32x4 w; w.x = cvtpk(a[0], a[1]); w.y = cvtpk(a[2], a[3]); w.z = cvtpk(b[0], b[1]); w.w = cvtpk(b[2], b[3]);
    *((u32x4*)dst + lane) = w;
}
__device__ __forceinline__ void norm_row512(bf16_t* row, const float* g, float* fout, int lane) {
    const u32x4 r = *((const u32x4*)row + lane);
    float v[8] = {bf_lo(r.x), bf_hi(r.x), bf_lo(r.y), bf_hi(r.y), bf_lo(r.z), bf_hi(r.z), bf_lo(r.w), bf_hi(r.w)};
    float s = 0.f;
#pragma unroll
    for (int i = 0; i < 8; ++i) s += v[i] * v[i];
    const float rstd = 1.0f / sqrtf(wave_sum(s) * (1.f / 512.f) + EPS);
    const f32x4 g0 = *((const f32x4*)g + 2 * lane), g1 = *((const f32x4*)g + 2 * lane + 1);
    f32x4 o0, o1;
#pragma unroll
    for (int i = 0; i < 4; ++i) { o0[i] = v[i] * rstd * g0[i]; o1[i] = v[4 + i] * rstd * g1[i]; }
    u32x4 w; w.x = cvtpk(o0[0], o0[1]); w.y = cvtpk(o0[2], o0[3]); w.z = cvtpk(o1[0], o1[1]); w.w = cvtpk(o1[2], o1[3]);
    *((u32x4*)row + lane) = w;
    if (fout) { *((f32x4*)fout + 2 * lane) = o0; *((f32x4*)fout + 2 * lane + 1) = o1; }
}

__device__ __forceinline__ void kmax_row(const float (&v)[8], int stream, LAS unsigned* kml, int lane) {
    float s = 0.f;
#pragma unroll
    for (int i = 0; i < 8; ++i) s += v[i] * v[i];
    s += __shfl_xor(s, 1); s += __shfl_xor(s, 2); s += __shfl_xor(s, 4); s += __shfl_xor(s, 8);
    if ((lane & 15) == 0) __hip_atomic_fetch_max(kml + stream * 4 + (lane >> 4), __float_as_uint(s), __ATOMIC_RELAXED, __HIP_MEMORY_SCOPE_WORKGROUP);
}
__device__ __forceinline__ void cvt_row512_kmax(const float* src, bf16_t* dst, int lane, int stream, LAS unsigned* kml) {
    const f32x4 a = __builtin_nontemporal_load((const f32x4*)src + 2 * lane), b = __builtin_nontemporal_load((const f32x4*)src + 2 * lane + 1);
    u32x4 w; w.x = cvtpk(a[0], a[1]); w.y = cvtpk(a[2], a[3]); w.z = cvtpk(b[0], b[1]); w.w = cvtpk(b[2], b[3]);
    *((u32x4*)dst + lane) = w;
    const float v[8] = {bf_lo(w.x), bf_hi(w.x), bf_lo(w.y), bf_hi(w.y), bf_lo(w.z), bf_hi(w.z), bf_lo(w.w), bf_hi(w.w)};
    kmax_row(v, stream, kml, lane);
}
__device__ __forceinline__ void kmax_flush(LAS unsigned* kml, unsigned* gk, int tid) {
    __syncthreads();
    if (tid < 40) { const unsigned v = kml[tid]; if (v) __hip_atomic_fetch_max(gk + tid, v, __ATOMIC_RELAXED, __HIP_MEMORY_SCOPE_AGENT); kml[tid] = 0u; }
    __syncthreads();
}

__device__ __forceinline__ void norm512_regs(const u32x4 r, const f32x4 g0, const f32x4 g1, bf16_t* row, float* fout, int lane) {
    float v[8] = {bf_lo(r.x), bf_hi(r.x), bf_lo(r.y), bf_hi(r.y), bf_lo(r.z), bf_hi(r.z), bf_lo(r.w), bf_hi(r.w)};
    float s = 0.f;
#pragma unroll
    for (int i = 0; i < 8; ++i) s += v[i] * v[i];
    const float rstd = 1.0f / sqrtf(wave_sum(s) * (1.f / 512.f) + EPS);
    f32x4 o0, o1;
#pragma unroll
    for (int i = 0; i < 4; ++i) { o0[i] = v[i] * rstd * g0[i]; o1[i] = v[4 + i] * rstd * g1[i]; }
    u32x4 w; w.x = cvtpk(o0[0], o0[1]); w.y = cvtpk(o0[2], o0[3]); w.z = cvtpk(o1[0], o1[1]); w.w = cvtpk(o1[2], o1[3]);
    *((u32x4*)row + lane) = w;
    if (fout) { __builtin_nontemporal_store(o0, (f32x4*)fout + 2 * lane); __builtin_nontemporal_store(o1, (f32x4*)fout + 2 * lane + 1); }
}

__device__ __forceinline__ void ssq_reduce(const float* ssp, float* ssq, int t0, int stride) {
    for (int r = t0; r < MP; r += stride) { const f32x4* p = (const f32x4*)(ssp + (size_t)r * 32); float s = 0.f;
#pragma unroll
        for (int j = 0; j < 8; ++j) { const f32x4 v = p[j]; s += (v[0] + v[1]) + (v[2] + v[3]); }
        ssq[r] = s; }
}
namespace att {
typedef short v4i16_t __attribute__((ext_vector_type(4)));
#ifndef SM_THR
#define SM_THR 8.0f
#endif
constexpr int IMG_K = 0, IMG_V = 16384, IMG_R = 32768, SLOT_BYTES = 40960, NSLOT = 3;
constexpr int OFF_BIAS = NSLOT * SLOT_BYTES, OFF_SLOT = OFF_BIAS + 1040, OFF_DONE = OFF_SLOT + 16, STAGE_ROWB = 272, STAGE_WAVE = 32 * STAGE_ROWB;
static_assert(8 * STAGE_WAVE <= OFF_BIAS && OFF_DONE + 32 <= RING_BYTES, "attention LDS map");
struct Tens { const bf16_t* Q; int qpitch; const bf16_t* K; const bf16_t* KR; const bf16_t* V; bf16_t* HEADS; const float* gh; const float* bias; };
__device__ __forceinline__ s16x4 vtr(const LAS unsigned char* p) { return __builtin_bit_cast(s16x4, __builtin_amdgcn_ds_read_tr16_b64_v4i16((LAS v4i16_t*)p)); }
#define ATT_MFMA(a, b, c) __builtin_amdgcn_mfma_f32_32x32x16_bf16((a), (b), (c), 0, 0, 0)
#define ATT_BAR() do { asm volatile("s_waitcnt lgkmcnt(0)" ::: "memory"); __builtin_amdgcn_s_barrier(); asm volatile("" ::: "memory"); } while (0)

template <int VAR>
__device__ __forceinline__ void attn_unit(LAS unsigned char* lds, const Tens& T, int head, int qrow0, int nw, int krow0, int qrel0, float kmax2) {
    constexpr int DQK = VAR == 0 ? 192 : 128, KS = DQK / 16;
    const int tid = fresh_tid(), w = __builtin_amdgcn_readfirstlane(tid >> 6), lane = tid & 63, r = lane & 31, h = lane >> 5;
    const bool active = w < nw;
    const int qw = qrel0 + 32 * w;
    int t_lo = 0, t_hi;
    if (VAR == 0) t_hi = (qrel0 + 32 * (nw - 1)) >> 6;
    else if (VAR == 1) { t_lo = (qrel0 >> 6) - 8; if (t_lo < 0) t_lo = 0; t_hi = (qrel0 + 32 * (nw - 1)) >> 6; }
    else t_hi = (qrel0 + 32 * (nw - 1) + 30) >> 6;
    const int nt = t_hi - t_lo + 1;
    unsigned oK[2];
#pragma unroll
    for (int i = 0; i < 2; ++i) { const int p = 64 * (w + 8 * i) + lane, row = p >> 4, pos = p & 15, ch = pos ^ (((row & 3) << 2) | ((row >> 2) & 3));
        oK[i] = (unsigned)(((krow0 + row) * 512 + 128 * head + 8 * ch) * 2); }
    unsigned oR = 0;
    if (VAR == 0) { const int p = 64 * w + lane, row = p >> 3, pos = p & 7, ch = pos ^ ((row >> 1) & 7); oR = (unsigned)(((krow0 + row) * 64 + 8 * ch) * 2); }
    const char* gKb = (const char*)T.K; const char* gVb = (const char*)T.V; const char* gRb = (const char*)T.KR;
#define ATT_DMA(kt_, slot_) do { LAS unsigned char* sb_ = lds + (slot_) * SLOT_BYTES + w * 1024; \
        _Pragma("unroll") for (int i_ = 0; i_ < 2; ++i_) { \
            __builtin_amdgcn_global_load_lds((const unsigned*)(gKb + (size_t)(kt_) * 65536 + oK[i_]), (LAS unsigned*)(sb_ + IMG_K + i_ * 8192), 16, 0, 0); \
            __builtin_amdgcn_global_load_lds((const unsigned*)(gVb + (size_t)(kt_) * 65536 + oK[i_]), (LAS unsigned*)(sb_ + IMG_V + i_ * 8192), 16, 0, 0); } \
        if (VAR == 0) __builtin_amdgcn_global_load_lds((const unsigned*)(gRb + (size_t)(kt_) * 8192 + oR), (LAS unsigned*)(sb_ + IMG_R), 16, 0, 0); } while (0)
#define ATT_WAIT_TILE(more_) do { if (more_) { if (VAR == 0) asm volatile("s_waitcnt vmcnt(5)" ::: "memory"); else asm volatile("s_waitcnt vmcnt(4)" ::: "memory"); } else asm volatile("s_waitcnt vmcnt(0)" ::: "memory"); } while (0)
#define ATT_TILE(i_) ((VAR == 2) ? (t_hi - (i_)) : (t_lo + (i_)))
    ATT_DMA(ATT_TILE(0), 0); if (nt > 1) ATT_DMA(ATT_TILE(1), 1);
    bf16x8 qf[KS];
    { const bf16_t* qp = T.Q + (size_t)(qrow0 + 32 * (active ? w : 0) + r) * T.qpitch + head * DQK + 8 * h;
#pragma unroll
      for (int ds = 0; ds < KS; ++ds) qf[ds] = *(const bf16x8*)(qp + 16 * ds); }
    if (VAR == 1) { LAS float* bl = (LAS float*)(lds + OFF_BIAS); if (tid < 257) bl[tid] = T.bias[tid] * LOG2E; }
    volatile LAS int* doneit = (volatile LAS int*)(lds + OFF_DONE);
    float zb = 0.f;
    if (VAR == 2) {
        if (tid < 8) doneit[tid] = (tid < nw) ? 0x7fffffff : -1;
        float qs = 0.f;
#pragma unroll
        for (int ds = 0; ds < KS; ++ds)
#pragma unroll
            for (int e = 0; e < 8; ++e) { const float qv = __uint_as_float(((unsigned)(unsigned short)qf[ds][e]) << 16); qs += qv * qv; }
        qs += __shfl_xor(qs, 32);
        zb = sqrtf(qs * kmax2) * 1.02f + 1.0f;
    }
    bool wdone = false;
    asm volatile("s_waitcnt vmcnt(0)" ::: "memory");
    ATT_BAR();
    f32x16 o[4];
#pragma unroll
    for (int d = 0; d < 4; ++d)
#pragma unroll
        for (int i = 0; i < 16; ++i) o[d][i] = 0.f;
    float m_run = 0.f, l_run = 0.f, carry = 0.f; bool first = true;
    const int i16 = lane & 15, q4 = i16 >> 2, p4 = i16 & 3, blk = (lane >> 4) & 1;
    const int swl = ((r & 3) << 2) | ((r >> 2) & 3);
    const int krow = IMG_K + 256 * r, rrow = IMG_R + 128 * r, rsw = (r >> 1) & 7;
    const int vlow = 2 * blk + (p4 >> 1);
    const int vb0 = IMG_V + 256 * (4 * h + q4) + 16 * (vlow ^ (h & 3)) + 8 * (p4 & 1);
    const int vb1 = IMG_V + 256 * (4 * h + q4 + 8) + 16 * (vlow ^ ((h + 2) & 3)) + 8 * (p4 & 1);
    u32x4 pk[4];
#define ATT_PV(sl_) do { const LAS unsigned char* vs_ = (sl_); \
        _Pragma("unroll") for (int ks_ = 0; ks_ < 4; ++ks_) { const bf16x8 pf_ = __builtin_bit_cast(bf16x8, pk[ks_]); \
            _Pragma("unroll") for (int db_ = 0; db_ < 4; ++db_) { const int dx_ = ((db_ ^ q4) << 6) + 4096 * ks_; \
                const s16x4 lo_ = vtr(vs_ + vb0 + dx_), hi_ = vtr(vs_ + vb1 + dx_); const bf16x8 vf_ = __builtin_shufflevector(lo_, hi_, 0, 1, 2, 3, 4, 5, 6, 7); o[db_] = ATT_MFMA(vf_, pf_, o[db_]); } \
            asm volatile("" ::: "memory"); } } while (0)
    int slot = 0;
    for (int it = 0; it < nt; ++it) {
        if (VAR == 2 && it > 0) { int c = 0;
#pragma unroll
            for (int j = 0; j < 8; ++j) c += (doneit[j] < it) ? 1 : 0;
            if (c == 8) break; }
        const bool more2 = it + 2 < nt;
        { int s2 = slot + 2; if (s2 >= NSLOT) s2 -= NSLOT; if (more2) ATT_DMA(ATT_TILE(it + 2), s2); }
        const int kt = ATT_TILE(it);
        const LAS unsigned char* sl = lds + slot * SLOT_BYTES;
        bool vis;
        if (VAR == 0) vis = kt <= (qw >> 6);
        else if (VAR == 1) vis = kt <= (qw >> 6) && kt >= (qw >> 6) - 8;
        else vis = 64 * kt <= qw + 30;
        if (active && vis && !wdone) {
            f32x16 x0, x1;
#pragma unroll
            for (int i = 0; i < 16; ++i) { x0[i] = 0.f; x1[i] = 0.f; }
            {
                bf16x8 ke0[4], ke1[4], kf0[4], kf1[4];
#define ATT_KLOAD(a0_, a1_, g_) do { _Pragma("unroll") for (int j_ = 0; j_ < 4; ++j_) { const int ds_ = 4 * (g_) + j_; \
                    const LAS unsigned char* ka_ = (ds_ < 8) ? sl + krow + 16 * ((2 * ds_ + h) ^ swl) : sl + rrow + 16 * ((2 * (ds_ - 8) + h) ^ rsw); \
                    const int kstep_ = (ds_ < 8) ? 32 * 256 : 32 * 128;                                         \
                    a0_[j_] = *(const LAS bf16x8*)(ka_); a1_[j_] = *(const LAS bf16x8*)(ka_ + kstep_); } } while (0)
                ATT_KLOAD(ke0, ke1, 0);
                __builtin_amdgcn_sched_barrier(0);
#pragma unroll
                for (int g = 0; g < KS / 4; ++g) {
                    if (g + 1 < KS / 4) { if (g & 1) ATT_KLOAD(ke0, ke1, g + 1); else ATT_KLOAD(kf0, kf1, g + 1); }
#pragma unroll
                    for (int j = 0; j < 4; ++j) { const int ds = 4 * g + j;
                        if (g & 1) { x0 = ATT_MFMA(kf0[j], qf[ds], x0); x1 = ATT_MFMA(kf1[j], qf[ds], x1); } else { x0 = ATT_MFMA(ke0[j], qf[ds], x0); x1 = ATT_MFMA(ke1[j], qf[ds], x1); } }
                    __builtin_amdgcn_sched_barrier(0);
                }
#undef ATT_KLOAD
            }
            if (VAR != 2) {
                if (VAR == 1) {
                    const LAS float* bl = (const LAS float*)(lds + OFF_BIAS);
                    if (qw - (64 * kt + 63) >= 128) { const float bc = bl[256];
#pragma unroll
                        for (int i = 0; i < 16; ++i) { x0[i] += bc; x1[i] += bc; } }
                    else { const int dq = qw + r - 64 * kt - 4 * h + 128;
#pragma unroll
                        for (int i = 0; i < 16; ++i) { int d0 = dq - ((i & 3) + 8 * (i >> 2)); int d1 = d0 - 32;
                            d0 = d0 < 0 ? 0 : (d0 > 256 ? 256 : d0); d1 = d1 < 0 ? 0 : (d1 > 256 ? 256 : d1); x0[i] += bl[d0]; x1[i] += bl[d1]; } }
                }
                float mx = x0[0];
#pragma unroll
                for (int i = 1; i < 16; ++i) mx = fmaxf(mx, x0[i]);
#pragma unroll
                for (int i = 0; i < 16; ++i) mx = fmaxf(mx, x1[i]);
                mx = fmaxf(mx, __shfl_xor(mx, 32)) - m_run;
                float ps = 0.f;
                const float dlt = first ? mx : (mx > SM_THR ? mx : 0.f);
                const bool moved = __any(first || mx > SM_THR);
                first = false;
                m_run += dlt;
#pragma unroll
                for (int i = 0; i < 16; ++i) { x0[i] = __builtin_amdgcn_exp2f(x0[i] - m_run); x1[i] = __builtin_amdgcn_exp2f(x1[i] - m_run); ps += x0[i] + x1[i]; }
                if (moved) {
                    const float alpha = __builtin_amdgcn_exp2f(-dlt);
                    l_run *= alpha;
#pragma unroll
                    for (int d = 0; d < 4; ++d)
#pragma unroll
                        for (int i = 0; i < 16; ++i) o[d][i] *= alpha;
                }
                l_run += ps;
            } else {
                const int q = qw + r, kbase = 64 * kt + 4 * h;
                const bool diag = (64 * kt + 63 >= qw);
                float tot = 0.f;
#pragma unroll
                for (int kbi = 1; kbi >= 0; --kbi) {
#pragma unroll
                    for (int g = 3; g >= 0; --g) {
                        float zz[4], lk[4]; bool vl[4];
#pragma unroll
                        for (int jj = 0; jj < 4; ++jj) { const int i = 4 * g + jj; zz[jj] = kbi ? x1[i] : x0[i]; vl[jj] = !diag || (kbase + 32 * kbi + 8 * g + jj) < q;
                            const float sp = fmaxf(zz[jj], 0.f) + __builtin_amdgcn_logf(1.f + __builtin_amdgcn_exp2f(-fabsf(zz[jj])));
                            lk[jj] = vl[jj] ? -sp : 0.f; }
                        const float s3 = lk[3], s2 = lk[2] + s3, s1 = lk[1] + s2, s0 = lk[0] + s1;
                        const float tp = __shfl_xor(s0, 32);
                        const float base = carry + tot + (h == 0 ? tp : 0.f);
                        const float sx[4] = {s0, s1, s2, s3};
#pragma unroll
                        for (int jj = 0; jj < 4; ++jj) { const int i = 4 * g + jj; const float wv = vl[jj] ? __builtin_amdgcn_exp2f(zz[jj] + sx[jj] + base) : 0.f; if (kbi) x1[i] = wv; else x0[i] = wv; }
                        tot += s0 + tp;
                    }
                }
                carry += tot;
                if (__all(zb + carry < -150.f)) { wdone = true; if (lane == 0) doneit[w] = it; }
            }
            __builtin_amdgcn_sched_barrier(0);
#pragma unroll
            for (int s2 = 0; s2 < 2; ++s2) {
                pk[s2].x = cvtpk(x0[8 * s2 + 0], x0[8 * s2 + 1]); pk[s2].y = cvtpk(x0[8 * s2 + 2], x0[8 * s2 + 3]); pk[s2].z = cvtpk(x0[8 * s2 + 4], x0[8 * s2 + 5]); pk[s2].w = cvtpk(x0[8 * s2 + 6], x0[8 * s2 + 7]);
                pk[2 + s2].x = cvtpk(x1[8 * s2 + 0], x1[8 * s2 + 1]); pk[2 + s2].y = cvtpk(x1[8 * s2 + 2], x1[8 * s2 + 3]); pk[2 + s2].z = cvtpk(x1[8 * s2 + 4], x1[8 * s2 + 5]); pk[2 + s2].w = cvtpk(x1[8 * s2 + 6], x1[8 * s2 + 7]);
            }
            ATT_PV(sl);
        }
        ATT_WAIT_TILE(more2);
        ATT_BAR();
        if (++slot == NSLOT) slot = 0;
    }
    asm volatile("s_waitcnt vmcnt(0)" ::: "memory"); ATT_BAR();
#undef ATT_PV
    if (active) {
        float inv = 1.f;
        if (VAR != 2) { const float l = l_run + __shfl_xor(l_run, 32); inv = 1.f / l; }
        float ss = 0.f;
#pragma unroll
        for (int d = 0; d < 4; ++d)
#pragma unroll
            for (int i = 0; i < 16; ++i) { o[d][i] *= inv; ss += o[d][i] * o[d][i]; }
        ss += __shfl_xor(ss, 32);
        const float rstd = 1.0f / sqrtf(ss * (1.f / 128.f) + EPS);
        LAS unsigned char* st = lds + w * STAGE_WAVE;
#pragma unroll
        for (int d = 0; d < 4; ++d)
#pragma unroll
            for (int g = 0; g < 4; ++g) { const int d0 = 32 * d + 8 * g + 4 * h; const f32x4 gv = *(const f32x4*)(T.gh + d0);
                u32x2 pkk; pkk.x = cvtpk(o[d][4 * g] * rstd * gv[0], o[d][4 * g + 1] * rstd * gv[1]); pkk.y = cvtpk(o[d][4 * g + 2] * rstd * gv[2], o[d][4 * g + 3] * rstd * gv[3]);
                *(LAS u32x2*)(st + r * STAGE_ROWB + d0 * 2) = pkk; }
        LDS_WAIT(); asm volatile("" ::: "memory");
#pragma unroll
        for (int j = 0; j < 8; ++j) { const int c = lane + 64 * j, row = c >> 4, cc = c & 15;
            const u32x4 v = *(const LAS u32x4*)(st + row * STAGE_ROWB + cc * 16);
            *(u32x4*)(T.HEADS + (size_t)(qrow0 + 32 * w + row) * NMIX + (VAR * 4 + head) * 128 + cc * 8) = v; }
    }
#undef ATT_DMA
#undef ATT_WAIT_TILE
#undef ATT_TILE
}

template <int VAR>
__device__ __forceinline__ void attn_queue(LAS unsigned char* lds, const Tens& T, unsigned* ctr8, int xcc, const float* gheads, const float* relbias, const unsigned* kmaxw) {
    volatile LAS unsigned* slot = (volatile LAS unsigned*)(lds + OFF_SLOT);
    for (;;) {
        __syncthreads();
        if (threadIdx.x == 0) {
            unsigned got = 0xffffffffu;
            for (int qi = 0; qi < 8; ++qi) { const int list = (xcc + qi) & 7;
                if (__hip_atomic_load(ctr8 + list * 64, __ATOMIC_RELAXED, __HIP_MEMORY_SCOPE_AGENT) >= 68u) continue;
                const unsigned u = __hip_atomic_fetch_add(ctr8 + list * 64, 1u, __ATOMIC_RELAXED, __HIP_MEMORY_SCOPE_AGENT);
                if (u < 68u) { got = ((unsigned)list << 8) | u; break; } }
            *slot = got;
        }
        __syncthreads();
        const unsigned g = (unsigned)__builtin_amdgcn_readfirstlane((int)*slot);
        if (g == 0xffffffffu) break;
        const int list = (int)(g >> 8), u = (int)(g & 255u);
        int head, qrow0, nw, krow0, qrel0, stream;
        if (u < 64) { const int qb = 63 - u, b = list >> 2; head = list & 3; qrow0 = b * SEQ + 256 * qb; nw = 8; krow0 = b * SEQ; qrel0 = 256 * qb; stream = b; }
        else { const int j = list * 4 + (u - 64), b = j >> 2; head = j & 3; qrow0 = MP + 64 * b; nw = 2; krow0 = MP + b * (VAR == 1 ? BSTR : CSTR); qrel0 = (VAR == 1) ? 512 : PAST; stream = 2 + b; }
        Tens t = T; t.gh = gheads + (VAR * 4 + head) * 128; t.bias = relbias + head * 257;
        float kmax2 = 0.f;
        if (VAR == 2) kmax2 = __uint_as_float(__hip_atomic_load(kmaxw + stream * 4 + head, __ATOMIC_RELAXED, __HIP_MEMORY_SCOPE_AGENT));
        attn_unit<VAR>(lds, t, head, qrow0, nw, krow0, qrel0, kmax2);
    }
}
}
__constant__ float c_inv_freq[32] = {1.000000000e+00f, 7.498942614e-01f, 5.623413324e-01f, 4.216965139e-01f, 3.162277639e-01f, 2.371373773e-01f, 1.778279394e-01f, 1.333521307e-01f,
    1.000000015e-01f, 7.498941571e-02f, 5.623413250e-02f, 4.216965288e-02f, 3.162277490e-02f, 2.371373773e-02f, 1.778279431e-02f, 1.333521493e-02f,
    9.999999776e-03f, 7.498941850e-03f, 5.623413250e-03f, 4.216964822e-03f, 3.162277630e-03f, 2.371373586e-03f, 1.778279431e-03f, 1.333521446e-03f,
    1.000000047e-03f, 7.498942432e-04f, 5.623413017e-04f, 4.216965172e-04f, 3.162277571e-04f, 2.371373703e-04f, 1.778279402e-04f, 1.333521504e-04f};

#ifndef PHASE_MASK
#define PHASE_MASK 0xFFFF
#endif
#ifndef WGM_RES
#define WGM_RES 4
#endif
#ifndef DUP_A
#define DUP_A 0
#endif
#ifndef DUP_UP
#define DUP_UP 0
#endif
#ifndef DUP_IN
#define DUP_IN 0
#endif
#ifndef DUP_W
#define DUP_W 0
#endif
#ifndef DUP_BC
#define DUP_BC 0
#endif
#ifndef DUP_N2
#define DUP_N2 0
#endif
struct Args { const float* in[25]; float* out; unsigned char* ws; };

constexpr int PTAB_OFF = RING_BYTES + 1024;
__device__ __forceinline__ const void* ldptr(volatile LAS unsigned long long* t_, int k) {
    unsigned tb = (unsigned)(size_t)t_; asm volatile("" : "+s"(tb));
    volatile LAS unsigned long long* t = (volatile LAS unsigned long long*)(size_t)tb;
    const unsigned long long v = t[k];
    const unsigned lo = (unsigned)__builtin_amdgcn_readfirstlane((int)(unsigned)v), hi = (unsigned)__builtin_amdgcn_readfirstlane((int)(unsigned)(v >> 32));
    return (const void*)(GAS const unsigned char*)(((unsigned long long)hi << 32) | lo);
}
#define P_IN(k) ((const float*)ldptr(ptab, (k)))
#define P_OUT() ((float*)ldptr(ptab, 25))
#define P_WS() ((unsigned char*)ldptr(ptab, 26))

__global__ void __launch_bounds__(512, 2) fwd_kernel(Args args) {
    extern __shared__ __attribute__((aligned(16))) unsigned char lds_raw[];
    LAS unsigned char* lds = (LAS unsigned char*)lds_raw;
    volatile LAS unsigned* MISC = (volatile LAS unsigned*)(lds + MISC_OFF);
    volatile LAS unsigned long long* ptab = (volatile LAS unsigned long long*)(lds + PTAB_OFF);
    const int tid = threadIdx.x;
    const int G = gridDim.x, NGW = G * 8;
    for (int u = tid; u < (LDS_BYTES - RING_BYTES) / 4; u += 512) ((LAS unsigned*)(lds + RING_BYTES))[u] = 0u;
    __syncthreads();
    if (tid < 25) ptab[tid] = (unsigned long long)args.in[tid];
    if (tid == 25) ptab[25] = (unsigned long long)args.out;
    if (tid == 26) ptab[26] = (unsigned long long)args.ws;
    __syncthreads();
    XcdBarrier bar = xcd_barrier_post((unsigned*)(args.ws + WS_CTL) + CW_BAR, MISC + 8);

    {
        f32x2* ROPE = (f32x2*)(P_WS() + WS_ROPE);
        for (int e = blockIdx.x * 512 + tid; e < SEQ * 32; e += G * 512) {
            const int pos = e >> 5, i = e & 31;
            const float ang = (float)pos * c_inv_freq[i];
            const double rev = (double)ang * 0.15915494309189535; const float fr = (float)(rev - floor(rev));
            ROPE[e] = (f32x2){__builtin_amdgcn_cosf(fr), __builtin_amdgcn_sinf(fr)};
        }
    }

    for (int l = 0; l < DEPTH; ++l) {
        if (PHASE_MASK & (1 << 0))
        for (int rep = 0; rep < 1 + DUP_W; ++rep)
        {
            const int tid = fresh_tid(), lane = tid & 63, wave = __builtin_amdgcn_readfirstlane(tid >> 6), gw = blockIdx.x * 8 + wave;
            unsigned char* ws = P_WS();
            LAS float* scr = (LAS float*)(lds + wave * 16384);
            constexpr int I_IN = 32 * 130, I_UQ = 8 * 24, I_UK = 8 * 16, I_OUT = 24 * 64, I_UP = 32 * 352, I_DN = 88 * 64, I_ALL = I_IN + I_UQ + 2 * I_UK + I_OUT + I_UP + I_DN;
            for (int it = gw; it < I_ALL; it += NGW) {
                int r = it;
                if (r < I_IN) { transpose_item(P_IN(10) + (size_t)l * DM * 4160, DM, 4160, (bf16_t*)(ws + WS_WIN), scr, r, lane, MapIn{}, P_IN(9) + (size_t)l * DM); continue; } r -= I_IN;
                if (r < I_UQ) { transpose_item(P_IN(12) + (size_t)l * 512 * 768, 512, 768, (bf16_t*)(ws + WS_WUQ), scr, r, lane, MapUq{}); continue; } r -= I_UQ;
                if (r < I_UK) { transpose_item(P_IN(14) + (size_t)l * 512 * 512, 512, 512, (bf16_t*)(ws + WS_WKV), scr, r, lane, MapOff{0}); continue; } r -= I_UK;
                if (r < I_UK) { transpose_item(P_IN(15) + (size_t)l * 512 * 512, 512, 512, (bf16_t*)(ws + WS_WKV), scr, r, lane, MapOff{512}); continue; } r -= I_UK;
                if (r < I_OUT) { transpose_item(P_IN(18) + (size_t)l * NMIX * DM, NMIX, DM, (bf16_t*)(ws + WS_WOUT), scr, r, lane, MapOff{0}); continue; } r -= I_OUT;
                if (r < I_UP) { transpose_item(P_IN(20) + (size_t)l * DM * NUP, DM, NUP, (bf16_t*)(ws + WS_WUP), scr, r, lane, MapUp{}, P_IN(19) + (size_t)l * DM); continue; } r -= I_UP;
                transpose_item(P_IN(23) + (size_t)l * DFF * DM, DFF, DM, (bf16_t*)(ws + WS_WDN), scr, r, lane, MapOff{0});
            }
            for (int it = gw; it < 40960; it += NGW) {
                if (it < 8192) { const int b = it >> 10, t = it & 1023; cvt_row512(P_IN(2) + ((size_t)(l * SB + b) * PAST + t) * 512, (bf16_t*)(ws + WS_CKV) + (size_t)(MP + b * CSTR + t) * 512, lane); }
                else if (it < 16384) { const int j = it - 8192, b = j >> 10, t = j & 1023;
                    if (lane < 32) { const float* s = P_IN(3) + ((size_t)(l * SB + b) * PAST + t) * 64; ((unsigned*)((bf16_t*)(ws + WS_KR) + (size_t)(MP + b * CSTR + t) * 64))[lane] = cvtpk(s[lane], s[lane + 32]); } }
                else if (it < 20480) { const int j = it - 16384, b = j >> 9, t = j & 511; cvt_row512(P_IN(4) + ((size_t)(l * SB + b) * 512 + t) * 512, (bf16_t*)(ws + WS_KB) + (size_t)(MP + b * BSTR + t) * 512, lane); }
                else if (it < 24576) { const int j = it - 20480, b = j >> 9, t = j & 511; cvt_row512(P_IN(5) + ((size_t)(l * SB + b) * 512 + t) * 512, (bf16_t*)(ws + WS_VB) + (size_t)(MP + b * BSTR + t) * 512, lane); }
                else if (it < 32768) { const int j = it - 24576, b = j >> 10, t = j & 1023; cvt_row512_kmax(P_IN(6) + ((size_t)(l * SB + b) * PAST + t) * 512, (bf16_t*)(ws + WS_KC) + (size_t)(MP + b * CSTR + t) * 512, lane, 2 + b, (LAS unsigned*)(lds + KMAXL_OFF)); }
                else { const int j = it - 32768, b = j >> 10, t = j & 1023; cvt_row512(P_IN(7) + ((size_t)(l * SB + b) * PAST + t) * 512, (bf16_t*)(ws + WS_VC) + (size_t)(MP + b * CSTR + t) * 512, lane); }
            }
            {
                bf16_t* XB = (bf16_t*)(ws + WS_H); float* ssq = (float*)(ws + WS_SSQ) + (size_t)(l * 2 + 0) * MT;
                if (l == 0) { const float* xp = P_IN(0); const float* xs = P_IN(1);
                    for (int m = gw; m < MT; m += NGW) prep_row_f32(m < MP ? xp + (size_t)m * DM : xs + (size_t)(m - MP) * DM, XB + (size_t)m * DM, ssq + m, lane); }
                else { const float* part = (const float*)(ws + WS_PART);
                    for (int m = MP + gw; m < MT; m += NGW) prep_row_bf(XB + (size_t)m * DM, ssq + m, lane, part + (size_t)(m - MP) * DM, NS_DOWN, (size_t)MS * DM);
                    ssq_reduce((const float*)(ws + WS_SSP), ssq, blockIdx.x * 512 + tid, G * 512); }
            }
            kmax_flush((LAS unsigned*)(lds + KMAXL_OFF), (unsigned*)(ws + WS_CTL) + CW_KMAX + l * 64, tid);
        }
        xcd_barrier(bar);

        if (PHASE_MASK & (1 << 1))
        for (int rep = 0; rep < 1 + DUP_IN; ++rep)
        {
            unsigned char* ws = P_WS();
            pg8::Gemm g{(const bf16_t*)(ws + WS_H), (const bf16_t*)(ws + WS_WIN), DM}; pg8::StaticOrder S; S.init(MT / 256, NIN / 256, G, (int)blockIdx.x, DM / 64);
            pg8::EpiIn E{ws, P_OUT(), l, (const float*)(ws + WS_SSQ) + (size_t)(l * 2 + 0) * MT};
            pg8::gemm_phase<pg8::EpiIn, pg8::StaticOrder, 0>(lds, g, S, E);
        }
        xcd_barrier(bar);

        if (PHASE_MASK & (1 << 2))
        {
            const int tid = fresh_tid(), lane = tid & 63, wave = __builtin_amdgcn_readfirstlane(tid >> 6), gw = blockIdx.x * 8 + wave;
            unsigned char* ws = P_WS(); float* out = P_OUT(); const float* gq = P_IN(11) + (size_t)l * 512; const float* gkv = P_IN(13) + (size_t)l * 512;
            bf16_t *CQ = (bf16_t*)(ws + WS_CQ), *CKV = (bf16_t*)(ws + WS_CKV), *KR = (bf16_t*)(ws + WS_KR); const f32x2* ROPE = (const f32x2*)(ws + WS_ROPE);
            const f32x4 gq0 = *((const f32x4*)gq + 2 * lane), gq1 = *((const f32x4*)gq + 2 * lane + 1), gk0 = *((const f32x4*)gkv + 2 * lane), gk1 = *((const f32x4*)gkv + 2 * lane + 1);
            const bf16_t* KC = (const bf16_t*)(ws + WS_KC);
            for (int m0 = 2 * gw; m0 < MT; m0 += 2 * NGW) {
                u32x4 rq[2], rk[2], rc[2]; unsigned rr[2] = {0u, 0u}; f32x2 cs[2] = {{0.f, 0.f}, {0.f, 0.f}}; int rowc[2];
#pragma unroll
                for (int j = 0; j < 2; ++j) { const int m = m0 + j; rowc[j] = pg8::map_c(m);
                    rq[j] = *((const u32x4*)(CQ + (size_t)m * 512) + lane); rk[j] = *((const u32x4*)(CKV + (size_t)rowc[j] * 512) + lane); rc[j] = *((const u32x4*)(KC + (size_t)rowc[j] * 512) + lane);
                    if (lane < 32) { const int pos = m >= MP ? PAST + ((m - MP) & 63) : (m & (SEQ - 1)); rr[j] = *((const unsigned*)(KR + (size_t)rowc[j] * 64) + lane); cs[j] = ROPE[(size_t)pos * 32 + lane]; } }
#pragma unroll
                for (int j = 0; j < 2; ++j) { const int m = m0 + j; const bool smp = m >= MP; const int ms = m - MP;
                    norm512_regs(rq[j], gq0, gq1, CQ + (size_t)m * 512, nullptr, lane);
                    float* ockv = smp ? out + O_SACKV + ((size_t)l * MS + ms) * 512 : out + O_PACKV + ((size_t)l * MP + m) * 512;
                    norm512_regs(rk[j], gk0, gk1, CKV + (size_t)rowc[j] * 512, ockv, lane);
                    if (lane < 32) {
                        const float x1 = bf_lo(rr[j]), x2 = bf_hi(rr[j]);
                        const float o1 = x1 * cs[j][0] - x2 * cs[j][1], o2 = x1 * cs[j][1] + x2 * cs[j][0];
                        *((unsigned*)(KR + (size_t)rowc[j] * 64) + lane) = cvtpk(o1, o2);
                        float* okr = smp ? out + O_SAKR + ((size_t)l * MS + ms) * 64 : out + O_PAKR + ((size_t)l * MP + m) * 64;
                        okr[lane] = o1; okr[lane + 32] = o2;
                    }
                    {
                        const u32x4 r = rc[j];
                        const float v[8] = {bf_lo(r.x), bf_hi(r.x), bf_lo(r.y), bf_hi(r.y), bf_lo(r.z), bf_hi(r.z), bf_lo(r.w), bf_hi(r.w)};
                        kmax_row(v, smp ? 2 + (ms >> 6) : (m >> 14), (LAS unsigned*)(lds + KMAXL_OFF), lane);
                    }
                }
            }
            kmax_flush((LAS unsigned*)(lds + KMAXL_OFF), (unsigned*)(ws + WS_CTL) + CW_KMAX + l * 64, tid);
        }
        xcd_barrier(bar);

        if (PHASE_MASK & (1 << 3))
        {
            unsigned char* ws = P_WS();
            pg8::Gemm g{(const bf16_t*)(ws + WS_CQ), (const bf16_t*)(ws + WS_WUQ), 512}; pg8::StaticOrder S; S.init(MT / 256, 3, G, (int)blockIdx.x, 8);
            pg8::EpiQ E{(bf16_t*)(ws + WS_QA), (const f32x2*)(ws + WS_ROPE)};
            pg8::gemm_phase<pg8::EpiQ, pg8::StaticOrder, 0>(lds, g, S, E);
        }
        if (PHASE_MASK & (1 << 4))
        {
            unsigned char* ws = P_WS();
            pg8::Gemm g{(const bf16_t*)(ws + WS_CKV), (const bf16_t*)(ws + WS_WKV), 512}; pg8::StaticOrder S; S.init(MC / 256, 4, G, (int)blockIdx.x, 8);
            pg8::EpiKV E{(bf16_t*)(ws + WS_KA), (bf16_t*)(ws + WS_VA)};
            pg8::gemm_phase<pg8::EpiKV, pg8::StaticOrder, 0>(lds, g, S, E);
        }
        xcd_barrier(bar);

        if (PHASE_MASK & (1 << 5))
        for (int rep = 0; rep < 1 + DUP_BC; ++rep)
        {   unsigned char* ws = P_WS();
            att::Tens T{(const bf16_t*)(ws + WS_QC), 512, (const bf16_t*)(ws + WS_KC), nullptr, (const bf16_t*)(ws + WS_VC), (bf16_t*)(ws + WS_HEADS), nullptr, nullptr};
            att::attn_queue<2>(lds, T, (unsigned*)(ws + WS_CTL) + CW_Q + ((rep ? 12 + l : l * 3 + 0) * 8) * 64, (int)bar.x, P_IN(17) + (size_t)l * NMIX, P_IN(16) + (size_t)l * 4 * 257, (const unsigned*)(ws + WS_CTL) + CW_KMAX + l * 64); }
        if (PHASE_MASK & (1 << 6))
        for (int rep = 0; rep < 1 + DUP_A; ++rep)
        {   unsigned char* ws = P_WS();
            att::Tens T{(const bf16_t*)(ws + WS_QA), 768, (const bf16_t*)(ws + WS_KA), (const bf16_t*)(ws + WS_KR), (const bf16_t*)(ws + WS_VA), (bf16_t*)(ws + WS_HEADS), nullptr, nullptr};
            att::attn_queue<0>(lds, T, (unsigned*)(ws + WS_CTL) + CW_Q + ((rep ? 16 + l : l * 3 + 1) * 8) * 64, (int)bar.x, P_IN(17) + (size_t)l * NMIX, P_IN(16) + (size_t)l * 4 * 257, nullptr); }
        if (PHASE_MASK & (1 << 7))
        for (int rep = 0; rep < 1 + DUP_BC; ++rep)
        {   unsigned char* ws = P_WS();
            att::Tens T{(const bf16_t*)(ws + WS_QB), 512, (const bf16_t*)(ws + WS_KB), nullptr, (const bf16_t*)(ws + WS_VB), (bf16_t*)(ws + WS_HEADS), nullptr, nullptr};
            att::attn_queue<1>(lds, T, (unsigned*)(ws + WS_CTL) + CW_Q + ((rep ? 20 + l : l * 3 + 2) * 8) * 64, (int)bar.x, P_IN(17) + (size_t)l * NMIX, P_IN(16) + (size_t)l * 4 * 257, nullptr); }
        xcd_barrier(bar);

        if (PHASE_MASK & (1 << 8))
        {
            unsigned char* ws = P_WS();
            pg8::Gemm g{(const bf16_t*)(ws + WS_HEADS), (const bf16_t*)(ws + WS_WOUT), NMIX}; pg8::TailOrder S; S.init(MP / 256, MS / 256, DM / 256, G, (int)blockIdx.x, NMIX / 64, NS_OUT, WGM_RES);
            pg8::EpiRes E{(bf16_t*)(ws + WS_H), (float*)(ws + WS_PART), NMIX / 64, (float*)(ws + WS_SSP)};
            pg8::gemm_phase<pg8::EpiRes, pg8::TailOrder, 0>(lds, g, S, E);
        }
        xcd_barrier(bar);

        if (PHASE_MASK & (1 << 9))
        for (int rep = 0; rep < 1 + DUP_N2; ++rep)
        {
            const int tid = fresh_tid(), lane = tid & 63, wave = __builtin_amdgcn_readfirstlane(tid >> 6), gw = blockIdx.x * 8 + wave;
            unsigned char* ws = P_WS(); bf16_t* XB = (bf16_t*)(ws + WS_H); const float* part = (const float*)(ws + WS_PART);
            float* ssq = (float*)(ws + WS_SSQ) + (size_t)(l * 2 + 1) * MT;
            for (int m = MP + gw; m < MT; m += NGW) prep_row_bf(XB + (size_t)m * DM, ssq + m, lane, part + (size_t)(m - MP) * DM, NS_OUT, (size_t)MS * DM);
            ssq_reduce((const float*)(ws + WS_SSP), ssq, blockIdx.x * 512 + tid, G * 512);
        }
        xcd_barrier(bar);

        if (PHASE_MASK & (1 << 10))
        for (int rep = 0; rep < 1 + DUP_UP; ++rep)
        {
            unsigned char* ws = P_WS(); float* out = P_OUT();
            pg8::Gemm g{(const bf16_t*)(ws + WS_H) - 2 * DM, (const bf16_t*)(ws + WS_WUP), DM}; pg8::StaticOrder S; S.init(132, NUP / 256, G, (int)blockIdx.x, DM / 64);
            pg8::EpiUp E{(bf16_t*)(ws + WS_ACT), P_IN(21) + (size_t)l * 3 * NUP, P_IN(22) + (size_t)l * NUP, (float*)(ws + WS_SIDE), out + O_PCONV + (size_t)l * NB * 2 * NUP, out + O_SCONV + (size_t)l * SB * 2 * NUP, (const float*)(ws + WS_SSQ) + (size_t)(l * 2 + 1) * MT, lds + XCH_OFF};
            pg8::gemm_phase<pg8::EpiUp, pg8::StaticOrder, 2>(lds, g, S, E);
        }
        xcd_barrier(bar);

        if (PHASE_MASK & (1 << 12))
        {
            const int tid = fresh_tid();
            unsigned char* ws = P_WS(); const float* w_conv = P_IN(21); const float* b_conv = P_IN(22); const float* state_conv = P_IN(8); bf16_t* ACT = (bf16_t*)(ws + WS_ACT);
            for (int e = blockIdx.x * 512 + tid; e < 20 * DFF; e += G * 512) {
                const int rs = e / DFF, j = e - rs * DFF, sq = rs >> 1, ts = rs & 1;
                const float* sd = (const float*)(ws + WS_SIDE) + (size_t)sq * 2 * NUP; const float* wc3 = w_conv + (size_t)l * 3 * NUP; const float* bc = b_conv + (size_t)l * NUP;
                float cv[2];
#pragma unroll
                for (int part = 0; part < 2; ++part) { const int col = part * DFF + j;
                    float s0 = 0.f, s1 = 0.f; if (sq >= 2) { const float* st = state_conv + ((size_t)l * SB + (sq - 2)) * 2 * NUP; s0 = st[col]; s1 = st[NUP + col]; }
                    const float ut = sd[ts * NUP + col], u1 = ts ? sd[col] : s1, u2 = ts ? s1 : s0;
                    cv[part] = bc[col] + wc3[col] * u2 + wc3[NUP + col] * u1 + wc3[2 * NUP + col] * ut; }
                const int row = (sq < 2 ? sq * SEQ : MP + (sq - 2) * SS) + ts;
                const float r = cv[0] * __builtin_amdgcn_rcpf(1.f + __expf(-cv[0])) * cv[1];
                ACT[(size_t)row * DFF + j] = (bf16_t)(cvtpk(r, 0.f) & 0xffffu);
            }
        }
        xcd_barrier(bar);

        if (PHASE_MASK & (1 << 11))
        {
            unsigned char* ws = P_WS();
            pg8::Gemm g{(const bf16_t*)(ws + WS_ACT), (const bf16_t*)(ws + WS_WDN), DFF}; pg8::TailOrder S; S.init(MP / 256, MS / 256, DM / 256, G, (int)blockIdx.x, DFF / 64, NS_DOWN, WGM_RES);
            pg8::EpiRes E{(bf16_t*)(ws + WS_H), (float*)(ws + WS_PART), DFF / 64, (float*)(ws + WS_SSP)};
            pg8::gemm_phase<pg8::EpiRes, pg8::TailOrder, 0>(lds, g, S, E);
        }
        xcd_barrier(bar);
    }
    {
        const int tid = fresh_tid(), lane = tid & 63, wave = __builtin_amdgcn_readfirstlane(tid >> 6), gw = blockIdx.x * 8 + wave;
        float* Y = P_OUT(); const float* gfin = P_IN(24);
        unsigned char* ws = P_WS(); const bf16_t* XB = (const bf16_t*)(ws + WS_H); const float* part = (const float*)(ws + WS_PART); const float* ssp = (const float*)(ws + WS_SSP);
        for (int m = gw; m < MT; m += NGW) { if (m < MP) final_row(XB + (size_t)m * DM, Y + (size_t)m * DM, gfin, lane, ssp + (size_t)m * 32); else final_row(XB + (size_t)m * DM, Y + (size_t)m * DM, gfin, lane, nullptr, part + (size_t)(m - MP) * DM, NS_DOWN, (size_t)MS * DM); }
    }
}

extern "C" void kernel_launch(void* const* d_in, const int* in_sizes, int n_in, void* d_out, int out_size, void* d_ws, size_t ws_size, hipStream_t stream) {
    static int grid = 0;
    if (grid == 0) {
        if (n_in != 25 || (size_t)out_size != O_END || ws_size < WS_END) { fprintf(stderr, "kernel_launch: unexpected sizes (n_in %d, out %d, ws %zu; need out %zu, ws >= %zu); nothing launched\n", n_in, out_size, ws_size, (size_t)O_END, (size_t)WS_END); grid = -1; return; }
        int dev = 0, cus = 0, per_cu = 0;
        if (hipGetDevice(&dev) != hipSuccess || hipDeviceGetAttribute(&cus, hipDeviceAttributeMultiprocessorCount, dev) != hipSuccess) { grid = -1; return; }
        if (hipFuncSetAttribute((const void*)fwd_kernel, hipFuncAttributeMaxDynamicSharedMemorySize, LDS_BYTES) != hipSuccess) { fprintf(stderr, "kernel_launch: hipFuncSetAttribute failed\n"); grid = -1; return; }
        if (hipOccupancyMaxActiveBlocksPerMultiprocessor(&per_cu, (const void*)fwd_kernel, 512, LDS_BYTES) != hipSuccess || per_cu < 1) fprintf(stderr, "kernel_launch: occupancy query reports %d\n", per_cu);
        (void)hipGetLastError();
        grid = cus;
    }
    if (grid < 0) return;
    if (hipMemsetAsync((char*)d_ws + WS_CTL, 0, CTL_ZERO_BYTES, stream) != hipSuccess) return;
    Args a{};
    for (int i = 0; i < 25; ++i) a.in[i] = (const float*)d_in[i];
    a.out = (float*)d_out; a.ws = (unsigned char*)d_ws;
    hipLaunchKernelGGL(fwd_kernel, dim3(grid), dim3(512), LDS_BYTES, stream, a);
}
```

```cpp
#include <hip/hip_runtime.h>
#include <cstdio>
#include <cstdint>

#define LAS __attribute__((address_space(3)))
#define GAS __attribute__((address_space(1)))
typedef unsigned short bf16_t;
typedef short bf16x8 __attribute__((ext_vector_type(8)));
typedef short s16x4 __attribute__((ext_vector_type(4)));
typedef float f32x2 __attribute__((ext_vector_type(2)));
typedef float f32x4 __attribute__((ext_vector_type(4)));
typedef float f32x16 __attribute__((ext_vector_type(16)));
typedef unsigned u32x2 __attribute__((ext_vector_type(2)));
typedef unsigned u32x4 __attribute__((ext_vector_type(4)));
typedef __bf16 bf16x2_t __attribute__((ext_vector_type(2)));

constexpr int DM = 2048, NB = 2, SEQ = 16384, DEPTH = 4, SB = 8, SS = 64, PAST = 1024;
constexpr int MP = NB * SEQ, MS = SB * SS, MT = MP + MS;
constexpr int CSTR = PAST + SS, BSTR = 512 + SS;
constexpr int MC = MP + SB * CSTR, MBB = MP + SB * BSTR;
constexpr int NIN = 4352, DFF = 5632, NUP = 2 * DFF, NMIX = 1536;
constexpr float EPS = 1e-6f;
constexpr float LOG2E = 1.4426950408889634f;
constexpr float SC_A = 0.07216878364870322f * LOG2E;
constexpr float SC_BC = 0.08838834764831845f * LOG2E;

constexpr size_t O_YP = 0, O_YS = O_YP + (size_t)MP * DM, O_PACKV = O_YS + (size_t)MS * DM, O_PAKR = O_PACKV + (size_t)DEPTH * MP * 512,
    O_PBK = O_PAKR + (size_t)DEPTH * MP * 64, O_PBV = O_PBK + (size_t)DEPTH * NB * 512 * 512, O_PCK = O_PBV + (size_t)DEPTH * NB * 512 * 512,
    O_PCV = O_PCK + (size_t)DEPTH * MP * 512, O_PCONV = O_PCV + (size_t)DEPTH * MP * 512, O_SACKV = O_PCONV + (size_t)DEPTH * NB * 2 * NUP,
    O_SAKR = O_SACKV + (size_t)DEPTH * MS * 512, O_SBK = O_SAKR + (size_t)DEPTH * MS * 64, O_SBV = O_SBK + (size_t)DEPTH * MS * 512,
    O_SCK = O_SBV + (size_t)DEPTH * MS * 512, O_SCV = O_SCK + (size_t)DEPTH * MS * 512, O_SCONV = O_SCV + (size_t)DEPTH * MS * 512,
    O_END = O_SCONV + (size_t)DEPTH * SB * 2 * NUP;

constexpr size_t AL(size_t x) { return (x + 4095) & ~(size_t)4095; }
constexpr size_t WS_CTL = 0, CTL_ZERO_BYTES = 1u << 20;
constexpr size_t WS_ROPE = CTL_ZERO_BYTES;
constexpr size_t WS_SIDE = WS_ROPE + (size_t)SEQ * 32 * 8;
constexpr size_t WS_WIN = AL(WS_SIDE + (size_t)10 * 2 * NUP * 4);
constexpr size_t WS_WUQ = WS_WIN + (size_t)NIN * DM * 2;
constexpr size_t WS_WKV = WS_WUQ + (size_t)768 * 512 * 2;
constexpr size_t WS_WOUT = WS_WKV + (size_t)1024 * 512 * 2;
constexpr size_t WS_WUP = WS_WOUT + (size_t)DM * NMIX * 2;
constexpr size_t WS_WDN = WS_WUP + (size_t)NUP * DM * 2;
constexpr size_t WS_HG = WS_WDN + (size_t)DM * DFF * 2;
constexpr size_t WS_H = WS_HG + 16384;
constexpr size_t WS_ATT = AL(WS_H + (size_t)(MT + 512) * DM * 2);
constexpr size_t WS_CQ = WS_ATT;
constexpr size_t WS_QA = WS_CQ + (size_t)MT * 512 * 2;
constexpr size_t WS_CKV = WS_QA + (size_t)MT * 768 * 2;
constexpr size_t WS_KR = WS_CKV + (size_t)MC * 512 * 2;
constexpr size_t WS_KA = WS_KR + (size_t)MC * 64 * 2;
constexpr size_t WS_VA = WS_KA + (size_t)MC * 512 * 2;
constexpr size_t WS_QB = WS_VA + (size_t)MC * 512 * 2;
constexpr size_t WS_KB = WS_QB + (size_t)MT * 512 * 2;
constexpr size_t WS_VB = WS_KB + (size_t)MBB * 512 * 2;
constexpr size_t WS_QC = WS_VB + (size_t)MBB * 512 * 2;
constexpr size_t WS_KC = WS_QC + (size_t)MT * 512 * 2;
constexpr size_t WS_VC = WS_KC + (size_t)MC * 512 * 2;
constexpr size_t WS_HEADS = WS_VC + (size_t)MC * 512 * 2;
constexpr size_t WS_ATT_END = WS_HEADS + (size_t)MT * NMIX * 2;
constexpr size_t WS_ACT = WS_ATT;
constexpr size_t WS_PART = AL((WS_ATT_END > WS_ACT + (size_t)MT * DFF * 2 ? WS_ATT_END : WS_ACT + (size_t)MT * DFF * 2) + 65536);
constexpr int NS_DOWN = 11, NS_OUT = 6;
constexpr size_t WS_SSQ = AL(WS_PART + (size_t)NS_DOWN * MS * DM * 4);
constexpr size_t SSQ_BYTES = (size_t)(DEPTH + 1) * 2 * MT * 4;
constexpr size_t WS_SSP = AL(WS_SSQ + SSQ_BYTES);
constexpr size_t WS_W2 = AL(WS_SSP + (size_t)MT * 32 * 4) + 65536;
constexpr size_t WALT = WS_W2 - WS_WIN;
constexpr size_t WS_END = AL(WS_W2 + (WS_HG - WS_WIN)) + 65536;
static_assert(WS_END < (size_t)1000 * 1000 * 1000, "workspace map");

constexpr int CW_BAR = 4096;
constexpr int CW_Q = 16384;
constexpr int CW_KMAX = 65536;
constexpr int KMAXL_OFF = 131072 + 2048;
constexpr int XCH_OFF = 131072 + 4096;

constexpr int RING_BYTES = 131072, MISC_OFF = RING_BYTES + 320, LDS_BYTES = 147456;

__device__ __forceinline__ unsigned cvtpk(float lo, float hi) { f32x2 v = {lo, hi}; bf16x2_t b = __builtin_convertvector(v, bf16x2_t); return __builtin_bit_cast(unsigned, b); }
__device__ __forceinline__ float bf_lo(unsigned u) { return __uint_as_float(u << 16); }
__device__ __forceinline__ float bf_hi(unsigned u) { return __uint_as_float(u & 0xffff0000u); }
__device__ __forceinline__ float wave_sum(float v) {
#pragma unroll
    for (int o = 1; o < 64; o <<= 1) v += __shfl_xor(v, o);
    return v;
}
#define LDS_WAIT() asm volatile("s_waitcnt lgkmcnt(0)" ::: "memory")
#define VM_WAIT() asm volatile("s_waitcnt vmcnt(0)" ::: "memory")
__device__ __forceinline__ int fresh_tid() { int t = threadIdx.x; asm volatile("" : "+v"(t)); return t; }
namespace pg8 {
constexpr int BM = 256, BK = 64, HALF = 128, HTB = HALF * BK * 2, STAGE_BYTES = 8 * HTB, NXCD = 8, WGM = 4;
__host__ __device__ __forceinline__ int lds_byte(int r, int c) { const int st = (r >> 4) * 2 + (c >> 5), rr = r & 15, cc = c & 31, ob = rr * 64 + cc * 2; return st * 1024 + (ob ^ (((ob >> 9) & 1) << 5)); }
__host__ __device__ __forceinline__ void stage_rc(int b, int& R, int& C) { const int st = b / 1024, sb = b % 1024, swz = sb ^ (((sb >> 9) & 1) << 5); R = (st >> 1) * 16 + swz / 64; C = (st & 1) * 32 + (swz % 64) / 2; }
__host__ __device__ __forceinline__ int perm32(int rho) { const int n = rho >> 4, i = rho & 15; return 8 * (i >> 2) + 4 * n + (i & 3); }

struct Unit { int pm, pn, k0, nk; };
struct Gemm { const bf16_t* A; const bf16_t* Bt; int K; };

struct StaticOrder {
    int nM, nN, nwg, G, c, nkt, wgm;
    __device__ void init(int nM_, int nN_, int G_, int c_, int nkt_, int wgm_ = WGM) { nM = nM_; nN = nN_; nwg = nM * nN; G = G_; c = c_; nkt = nkt_; wgm = wgm_; }
    __device__ void map(int wgid, Unit& u) const {
        { const int q = nwg / NXCD, r = nwg % NXCD, xcd = wgid % NXCD, off = wgid / NXCD; wgid = (xcd < r ? xcd * (q + 1) : r * (q + 1) + (xcd - r) * q) + off; }
        const int nig = wgm * nN, gid = wgid / nig, fm = gid * wgm, gsz = (nM - fm) < wgm ? (nM - fm) : wgm;
        u.pm = fm + ((wgid % nig) % gsz); u.pn = (wgid % nig) / gsz; u.k0 = 0; u.nk = nkt;
    }
    __device__ bool next(int i, Unit& u) const { const long L = (long)i * G + c; if (L >= nwg) return false; map((int)L, u); return true; }
};
struct TailOrder {
    StaticOrder so; int nMt, NS, nks;
    __device__ void init(int nMf, int nMt_, int nN, int G, int c, int nkt, int NS_, int wgm_ = WGM) { so.init(nMf, nN, G, c, nkt, wgm_); nMt = nMt_; NS = NS_; nks = nkt / NS_; }
    __device__ bool next(int i, Unit& u) const {
        const long L = (long)i * so.G + so.c;
        if (L < so.nwg) { so.map((int)L, u); return true; }
        const int r = (int)(L - so.nwg); if (r >= nMt * so.nN * NS) return false;
        const int s = r % NS, t = r / NS; u.pn = t % so.nN; u.pm = so.nM + t / so.nN; u.k0 = s * nks; u.nk = nks; return true;
    }
};

template <class Epi, class Sched, int AMODE>
__device__ __forceinline__ void gemm_phase(LAS unsigned char* lds, const Gemm g, const Sched& S, const Epi& E) {
    const int tid = fresh_tid(), wid = __builtin_amdgcn_readfirstlane(tid >> 6), lane = tid & 63, wr = wid >> 2, wc = wid & 3, fr = lane & 15, fq = lane >> 4;
    const int K = g.K;
    unsigned voffA[2], voffB[2];
#pragma unroll
    for (int i = 0; i < 2; ++i) { int R, C; stage_rc(tid * 16 + i * 8192, R, C); const int Rb = Epi::PERM ? ((R & ~31) + perm32(R & 31)) : R; const int Ra = (AMODE == 1) ? (62 * (R >> 6) + (R & 63)) : R;
        voffA[i] = (unsigned)(Ra * K + C) * 2u; voffB[i] = (unsigned)(Rb * K + C) * 2u; }
    const size_t kstep = (size_t)(BK * 2);
    const size_t hstepB = (size_t)HALF * K * 2, tstepB = 2 * hstepB;
    const size_t hstepA = (size_t)(AMODE == 1 ? 124 : 128) * K * 2, tstepA = (AMODE == 2) ? (size_t)254 * K * 2 : 2 * hstepA;
    const unsigned ldsw = (unsigned)wid * 1024u;
    const int aoff = lds_byte(wr * 64 + fr, fq * 8), boff = lds_byte(wc * 32 + fr, fq * 8);
#define PG8_SA(b, h) (((b) * 2 + (h)) * HTB)
#define PG8_SB(b, h) ((4 + (b) * 2 + (h)) * HTB)
#define PG8_STAGE(bufoff, gbase, voff) do { _Pragma("unroll") for (int _i = 0; _i < 2; ++_i) \
        __builtin_amdgcn_global_load_lds((const unsigned*)((const char*)(gbase) + (voff)[_i]), (LAS unsigned*)(lds + (bufoff) + ldsw + _i * 8192), 16, 0, 0); } while (0)
#define PG8_LDA(dst, b, h) do { _Pragma("unroll") for (int m = 0; m < 4; ++m) _Pragma("unroll") for (int k = 0; k < 2; ++k) dst[m][k] = *(const LAS bf16x8*)(lds + PG8_SA(b, h) + aoff + m * 2048 + k * 1024); } while (0)
#define PG8_LDB(dst, b, h) do { _Pragma("unroll") for (int n = 0; n < 2; ++n) _Pragma("unroll") for (int k = 0; k < 2; ++k) dst[n][k] = *(const LAS bf16x8*)(lds + PG8_SB(b, h) + boff + n * 2048 + k * 1024); } while (0)
#define PG8_MMA(ai, bj, At, Bt) do { __builtin_amdgcn_s_setprio(1); _Pragma("unroll") for (int m = 0; m < 4; ++m) _Pragma("unroll") for (int n = 0; n < 2; ++n) _Pragma("unroll") for (int k = 0; k < 2; ++k) \
        acc[ai][bj][m][n] = __builtin_amdgcn_mfma_f32_16x16x32_bf16(Bt[n][k], At[m][k], acc[ai][bj][m][n], 0, 0, 0); __builtin_amdgcn_s_setprio(0); } while (0)
#define PG8_WAIT_V(n) asm volatile("s_waitcnt vmcnt(" #n ")" ::: "memory")
#define PG8_WAIT_L(n) asm volatile("s_waitcnt lgkmcnt(" #n ")" ::: "memory")
#define PG8_BAR __builtin_amdgcn_s_barrier()
#define PG8_SCHED __builtin_amdgcn_sched_barrier(0)
    Unit cur, nxt; int ui = 0;
    if (!S.next(0, cur)) return;
    f32x4 acc[2][2][4][2];
#pragma unroll
    for (int a = 0; a < 2; ++a)
#pragma unroll
        for (int b = 0; b < 2; ++b)
#pragma unroll
            for (int m = 0; m < 4; ++m)
#pragma unroll
                for (int n = 0; n < 2; ++n) acc[a][b][m][n] = (f32x4){0.f, 0.f, 0.f, 0.f};
    bf16x8 At[4][2], B0[2][2], B1[2][2];
    const char* cA = (const char*)g.A + (size_t)cur.pm * tstepA + (size_t)cur.k0 * kstep; const char* cB = (const char*)g.Bt + (size_t)cur.pn * tstepB + (size_t)cur.k0 * kstep;
    PG8_STAGE(PG8_SB(0, 0), cB, voffB); PG8_STAGE(PG8_SB(0, 1), cB + hstepB, voffB); PG8_STAGE(PG8_SA(0, 0), cA, voffA); PG8_STAGE(PG8_SA(0, 1), cA + hstepA, voffA);
    if (wr == 1) PG8_BAR;
    PG8_WAIT_V(2); PG8_BAR;
    PG8_STAGE(PG8_SB(1, 0), cB + kstep, voffB); PG8_STAGE(PG8_SA(1, 0), cA + kstep, voffA); PG8_STAGE(PG8_SB(1, 1), cB + hstepB + kstep, voffB);
    PG8_WAIT_V(6); PG8_BAR;
    for (;;) {
        const bool has_next = S.next(ui + 1, nxt);
        const char* nA = has_next ? (const char*)g.A + (size_t)nxt.pm * tstepA + (size_t)nxt.k0 * kstep : cA; const char* nB = has_next ? (const char*)g.Bt + (size_t)nxt.pn * tstepB + (size_t)nxt.k0 * kstep : cB;
        const int nt = cur.nk;
        for (int t = 0; t < nt; t += 2) {
            const bool last = (t == nt - 2);
            const char* a1 = cA + (size_t)(t + 1) * kstep;
            const char* a2 = last ? nA : cA + (size_t)(t + 2) * kstep; const char* b2 = last ? nB : cB + (size_t)(t + 2) * kstep;
            const char* a3 = a2 + kstep; const char* b3 = b2 + kstep;
            PG8_LDB(B0, 0, 0); PG8_LDB(B1, 0, 1); PG8_SCHED; PG8_LDA(At, 0, 0); PG8_STAGE(PG8_SA(1, 1), a1 + hstepA, voffA);
            PG8_WAIT_V(8); PG8_WAIT_L(0); PG8_BAR; PG8_MMA(0, 0, At, B0); PG8_MMA(0, 1, At, B1); PG8_BAR; PG8_SCHED;
            PG8_LDA(At, 0, 1); PG8_STAGE(PG8_SB(0, 0), b2, voffB); PG8_STAGE(PG8_SB(0, 1), b2 + hstepB, voffB); PG8_STAGE(PG8_SA(0, 0), a2, voffA);
            PG8_WAIT_V(8); PG8_WAIT_L(0); PG8_BAR; PG8_MMA(1, 0, At, B0); PG8_MMA(1, 1, At, B1); PG8_BAR; PG8_SCHED;
            PG8_LDB(B0, 1, 0); PG8_LDB(B1, 1, 1); PG8_SCHED; PG8_LDA(At, 1, 0); PG8_STAGE(PG8_SA(0, 1), a2 + hstepA, voffA);
            PG8_WAIT_V(8); PG8_WAIT_L(0); PG8_BAR; PG8_MMA(0, 0, At, B0); PG8_MMA(0, 1, At, B1); PG8_BAR; PG8_SCHED;
            PG8_LDA(At, 1, 1); PG8_STAGE(PG8_SB(1, 0), b3, voffB); PG8_STAGE(PG8_SB(1, 1), b3 + hstepB, voffB); PG8_STAGE(PG8_SA(1, 0), a3, voffA);
            PG8_WAIT_V(8); PG8_WAIT_L(0); PG8_BAR; PG8_MMA(1, 0, At, B0); PG8_MMA(1, 1, At, B1); PG8_BAR; PG8_SCHED;
        }
        if (wr == 0) PG8_BAR;
        E(acc, cur, wr, wc, fr, fq);
        if (!has_next) break;
#pragma unroll
        for (int a = 0; a < 2; ++a)
#pragma unroll
            for (int b = 0; b < 2; ++b)
#pragma unroll
                for (int m = 0; m < 4; ++m)
#pragma unroll
                    for (int n = 0; n < 2; ++n) acc[a][b][m][n] = (f32x4){0.f, 0.f, 0.f, 0.f};
        cur = nxt; cA = nA; cB = nB; ++ui;
        if (wr == 1) PG8_BAR;
    }
    PG8_WAIT_V(0);
    PG8_BAR;
#undef PG8_SA
#undef PG8_SB
#undef PG8_STAGE
#undef PG8_LDA
#undef PG8_LDB
#undef PG8_MMA
#undef PG8_WAIT_V
#undef PG8_WAIT_L
#undef PG8_BAR
#undef PG8_SCHED
}
}
namespace pg8 {
template <int CTRL> __device__ __forceinline__ float dpp_f(float x) { return __builtin_bit_cast(float, __builtin_amdgcn_update_dpp(0, __builtin_bit_cast(int, x), CTRL, 0xf, 0xf, true)); }
__device__ __forceinline__ int map_c(int m) { if (m < MP) return m; const int ms = m - MP; return MP + (ms >> 6) * CSTR + PAST + (ms & 63); }
__device__ __forceinline__ int map_b(int m) { if (m < MP) return m; const int ms = m - MP; return MP + (ms >> 6) * BSTR + 512 + (ms & 63); }

struct EpiIn {
    static constexpr bool PERM = true;
    unsigned char* ws; float* out; int l; const float* ssq;
    __device__ __forceinline__ void operator()(const f32x4 (&acc)[2][2][4][2], const Unit& u, int wr, int wc, int fr, int fq) const {
        const int pn = u.pn; const bool smp = u.pm >= (MP / 256);
        size_t doff = WS_CQ, fbase = 0; int pitch = 512, sub = pn & 1, rowmode = 0, fkind = 0; float sc = 1.f;
        if (pn < 2) { doff = WS_CQ; }
        else if (pn < 4) { doff = WS_CKV; rowmode = 1; }
        else if (pn < 10) { const int w = (pn - 4) >> 1; if (w == 0) { doff = WS_QB; sc = SC_BC; } else { doff = (w == 1) ? WS_KB : WS_VB; rowmode = 2; fkind = 1;
                fbase = smp ? (w == 1 ? O_SBK : O_SBV) + (size_t)l * MS * 512 : (w == 1 ? O_PBK : O_PBV) + (size_t)l * NB * 512 * 512; } }
        else if (pn < 16) { const int w = (pn - 10) >> 1; if (w == 0) { doff = WS_QC; sc = SC_BC; } else { doff = (w == 1) ? WS_KC : WS_VC; rowmode = 1; fkind = 2;
                fbase = smp ? (w == 1 ? O_SCK : O_SCV) + (size_t)l * MS * 512 : (w == 1 ? O_PCK : O_PCV) + (size_t)l * MP * 512; } }
        else { doff = WS_KR; pitch = 64; sub = 0; rowmode = 1; }
        bf16_t* dst = (bf16_t*)(ws + doff); float* fo = out + fbase;
        const int lc0 = 256 * sub + 32 * wc + 8 * fq;
#pragma unroll
        for (int ai = 0; ai < 2; ++ai)
#pragma unroll
            for (int m = 0; m < 4; ++m) {
                const int mrow = u.pm * 256 + ai * 128 + wr * 64 + m * 16 + fr;
                const int drow = rowmode == 0 ? mrow : (rowmode == 1 ? map_c(mrow) : map_b(mrow));
                const float rs = 1.0f / sqrtf(ssq[mrow] * (1.f / DM) + EPS), scr = sc * rs;
                long foff = -1;
                if (fkind) {
                    if (smp) foff = (long)(mrow - MP) * 512;
                    else if (fkind == 2) foff = (long)mrow * 512;
                    else { const int t = mrow & (SEQ - 1), b = mrow >> 14; if (t >= SEQ - 512) foff = (long)(b * 512 + (t - (SEQ - 512))) * 512; }
                }
#pragma unroll
                for (int bj = 0; bj < 2; ++bj) {
                    const int lc = lc0 + bj * 128;
                    if (pn == 16 && lc >= 64) continue;
                    const f32x4 v0 = acc[ai][bj][m][0], v1 = acc[ai][bj][m][1];
                    u32x4 w; w.x = cvtpk(v0[0] * scr, v0[1] * scr); w.y = cvtpk(v0[2] * scr, v0[3] * scr); w.z = cvtpk(v1[0] * scr, v1[1] * scr); w.w = cvtpk(v1[2] * scr, v1[3] * scr);
                    *(u32x4*)(dst + (size_t)drow * pitch + lc) = w;
                    if (foff >= 0) { float* fp = fo + foff + lc; __builtin_nontemporal_store(v0 * rs, (f32x4*)fp); __builtin_nontemporal_store(v1 * rs, (f32x4*)(fp + 4)); }
                }
            }
    }
};

struct EpiQ {
    static constexpr bool PERM = true;
    bf16_t* QA; const f32x2* rope;
    __device__ __forceinline__ void operator()(const f32x4 (&acc)[2][2][4][2], const Unit& u, int wr, int wc, int fr, int fq) const {
#pragma unroll
        for (int bj = 0; bj < 2; ++bj) {
            const int c0 = 256 * u.pn + 128 * bj + 32 * wc + 8 * fq, j = c0 % 192; const bool isrope = j >= 128; const int i0 = (j - 128) >> 1;
#pragma unroll
            for (int ai = 0; ai < 2; ++ai)
#pragma unroll
                for (int m = 0; m < 4; ++m) {
                    const int mrow = u.pm * 256 + ai * 128 + wr * 64 + m * 16 + fr;
                    f32x4 v0 = acc[ai][bj][m][0], v1 = acc[ai][bj][m][1];
                    if (isrope) {
                        const int pos = mrow < MP ? (mrow & (SEQ - 1)) : PAST + ((mrow - MP) & 63);
                        const f32x4* cs = (const f32x4*)(rope + (size_t)pos * 32 + i0);
                        const f32x4 ca = cs[0], cb = cs[1];
                        f32x4 r0, r1;
                        r0[0] = v0[0] * ca[0] - v0[1] * ca[1]; r0[1] = v0[0] * ca[1] + v0[1] * ca[0];
                        r0[2] = v0[2] * ca[2] - v0[3] * ca[3]; r0[3] = v0[2] * ca[3] + v0[3] * ca[2];
                        r1[0] = v1[0] * cb[0] - v1[1] * cb[1]; r1[1] = v1[0] * cb[1] + v1[1] * cb[0];
                        r1[2] = v1[2] * cb[2] - v1[3] * cb[3]; r1[3] = v1[2] * cb[3] + v1[3] * cb[2];
                        v0 = r0; v1 = r1;
                    }
                    u32x4 w; w.x = cvtpk(v0[0] * SC_A, v0[1] * SC_A); w.y = cvtpk(v0[2] * SC_A, v0[3] * SC_A); w.z = cvtpk(v1[0] * SC_A, v1[1] * SC_A); w.w = cvtpk(v1[2] * SC_A, v1[3] * SC_A);
                    *(u32x4*)(QA + (size_t)mrow * 768 + c0) = w;
                }
        }
    }
};

struct EpiKV {
    static constexpr bool PERM = true;
    bf16_t *KA, *VA;
    __device__ __forceinline__ void operator()(const f32x4 (&acc)[2][2][4][2], const Unit& u, int wr, int wc, int fr, int fq) const {
        bf16_t* dst = (u.pn < 2) ? KA : VA; const int lc0 = 256 * (u.pn & 1) + 32 * wc + 8 * fq;
#pragma unroll
        for (int ai = 0; ai < 2; ++ai)
#pragma unroll
            for (int m = 0; m < 4; ++m) {
                const int row = u.pm * 256 + ai * 128 + wr * 64 + m * 16 + fr;
#pragma unroll
                for (int bj = 0; bj < 2; ++bj) {
                    const f32x4 v0 = acc[ai][bj][m][0], v1 = acc[ai][bj][m][1];
                    u32x4 w; w.x = cvtpk(v0[0], v0[1]); w.y = cvtpk(v0[2], v0[3]); w.z = cvtpk(v1[0], v1[1]); w.w = cvtpk(v1[2], v1[3]);
                    *(u32x4*)(dst + (size_t)row * 512 + lc0 + bj * 128) = w;
                }
            }
    }
};

struct EpiRes {
    static constexpr bool PERM = true;
    bf16_t* XB; float* part; int nkt; float* ssp;
    __device__ __forceinline__ void operator()(const f32x4 (&acc)[2][2][4][2], const Unit& u, int wr, int wc, int fr, int fq) const {
        const int col0 = u.pn * 256 + wc * 32 + 8 * fq;
        const bool split = u.nk != nkt;
        const int slice = split ? u.k0 / u.nk : 0;
#pragma unroll
        for (int ai = 0; ai < 2; ++ai)
#pragma unroll
            for (int m = 0; m < 4; ++m) {
                const int row = u.pm * 256 + ai * 128 + wr * 64 + m * 16 + fr;
                if (split) {
                    float* op = part + ((size_t)slice * MS + (size_t)(row - MP)) * DM + col0;
#pragma unroll
                    for (int bj = 0; bj < 2; ++bj) { *(f32x4*)(op + bj * 128) = acc[ai][bj][m][0]; *(f32x4*)(op + bj * 128 + 4) = acc[ai][bj][m][1]; }
                } else {
                    bf16_t* xp = XB + (size_t)row * DM + col0;
                    float s = 0.f;
#pragma unroll
                    for (int bj = 0; bj < 2; ++bj) {
                        const u32x4 b = *(const u32x4*)(xp + bj * 128);
                        const f32x4 a0 = acc[ai][bj][m][0], a1 = acc[ai][bj][m][1];
                        const float x0 = bf_lo(b.x) + a0[0], x1 = bf_hi(b.x) + a0[1], x2 = bf_lo(b.y) + a0[2], x3 = bf_hi(b.y) + a0[3], x4 = bf_lo(b.z) + a1[0], x5 = bf_hi(b.z) + a1[1], x6 = bf_lo(b.w) + a1[2], x7 = bf_hi(b.w) + a1[3];
                        s += (x0 * x0 + x1 * x1) + (x2 * x2 + x3 * x3) + (x4 * x4 + x5 * x5) + (x6 * x6 + x7 * x7);
                        u32x4 w; w.x = cvtpk(x0, x1); w.y = cvtpk(x2, x3); w.z = cvtpk(x4, x5); w.w = cvtpk(x6, x7);
                        *(u32x4*)(xp + bj * 128) = w;
                    }
                    s += __shfl_xor(s, 16); s += __shfl_xor(s, 32);
                    if (fq == 0) ssp[(size_t)row * 32 + u.pn * 4 + wc] = s;
                }
            }
    }
};

struct EpiUp {
    static constexpr bool PERM = true;
    bf16_t* ACT; const float *wconv, *bconv; float *side, *pconv, *sconv; const float* ssq; LAS unsigned char* xch;
    __device__ __forceinline__ void operator()(f32x4 (&acc)[2][2][4][2], const Unit& u, int wr_, int wc_, int fr_, int fq_) const {
        const bool rare_tile = u.pm == 0 || u.pm == 64 || u.pm >= 129;
        {
            int wr = wr_, wc = wc_, fr = fr_, fq = fq_; asm volatile("" : "+v"(fr), "+v"(fq)); asm volatile("" : "+s"(wr), "+s"(wc));
#pragma unroll
            for (int ai = 0; ai < 2; ++ai)
#pragma unroll
                for (int m = 0; m < 4; ++m) { int grow = 254 * u.pm + 128 * ai + 64 * wr + 16 * m + fr - 2; grow = grow < 0 ? 0 : (grow > MT - 1 ? MT - 1 : grow);
                    const float rs = 1.0f / sqrtf(ssq[grow] * (1.f / DM) + EPS);
#pragma unroll
                    for (int bj = 0; bj < 2; ++bj)
#pragma unroll
                        for (int n = 0; n < 2; ++n) acc[ai][bj][m][n] *= rs; }
            if (fr >= 14) {
#pragma unroll
                for (int ai = 0; ai < 2; ++ai)
#pragma unroll
                    for (int bj = 0; bj < 2; ++bj)
#pragma unroll
                        for (int n = 0; n < 2; ++n) *(LAS f32x4*)(xch + ((((((wc * 4 + 2 * ai + wr) * 2 + bj) * 2 + n) * 4 + fq) * 2) + (fr - 14)) * 16) = acc[ai][bj][3][n];
            }
            asm volatile("s_waitcnt lgkmcnt(0)" ::: "memory"); __builtin_amdgcn_s_barrier(); asm volatile("" ::: "memory");
            __builtin_amdgcn_sched_barrier(0);
        }
#pragma unroll
        for (int bj = 0; bj < 2; ++bj)
#pragma unroll
            for (int n = 0; n < 2; ++n) {
                int wr = wr_, wc = wc_, fr = fr_, fq = fq_;
                asm volatile("" : "+v"(fr), "+v"(fq));
                asm volatile("" : "+s"(wr), "+s"(wc));
                const int col = bj * DFF + 128 * u.pn + 32 * wc + 8 * fq + 4 * n;
                const f32x4 w0 = *(const f32x4*)(wconv + col), w1 = *(const f32x4*)(wconv + NUP + col), w2 = *(const f32x4*)(wconv + 2 * NUP + col), bb = *(const f32x4*)(bconv + col);
#pragma unroll
                for (int ai = 0; ai < 2; ++ai) {
                    const int gabove = 2 * ai + wr - 1;
                    const f32x4 xq = *(const LAS f32x4*)(xch + ((((((wc * 4 + (gabove < 0 ? 0 : gabove)) * 2 + bj) * 2 + n) * 4 + fq) * 2) + (fr & 1)) * 16);
#pragma unroll
                    for (int mm = 0; mm < 4; ++mm) {
                        const int m = 3 - mm;
                        const int R = 128 * ai + 64 * wr + 16 * m + fr, grow = 254 * u.pm + R - 2;
                        asm volatile("" : "+v"(acc[ai][bj][m][n]), "+v"(acc[ai][bj][m > 0 ? m - 1 : 0][n]));
                        const f32x4 v = acc[ai][bj][m][n], q = (m > 0) ? acc[ai][bj][m > 0 ? m - 1 : 0][n] : xq;
                        f32x4 p1, p2;
#pragma unroll
                        for (int c = 0; c < 4; ++c) { p1[c] = dpp_f<0x121>((fr == 15) ? q[c] : v[c]); p2[c] = dpp_f<0x122>((fr >= 14) ? q[c] : v[c]); }
                        if (rare_tile) {
                        const bool ok = R >= 2 && grow < MT, smp = grow >= MP;
                        const int g2 = smp ? grow - MP : grow, tseq = smp ? (g2 & 63) : (g2 & (SEQ - 1)), sq = smp ? 2 + (g2 >> 6) : (g2 >> 14), slen = smp ? SS : SEQ;
                        if (ok && (tseq < 2 || tseq >= slen - 2)) {
                            float* co = (tseq < 2) ? side + ((size_t)sq * 2 + tseq) * NUP : (smp ? sconv + ((size_t)(sq - 2) * 2 + (tseq - (SS - 2))) * NUP : pconv + ((size_t)sq * 2 + (tseq - (SEQ - 2))) * NUP);
                            *(f32x4*)(co + col) = v;
                        }
                        }
                        acc[ai][bj][m][n] = w0 * p2 + (w1 * p1 + (w2 * v + bb));
                        asm volatile("" : "+v"(acc[ai][bj][m][n]));
                    }
                }
                __builtin_amdgcn_sched_barrier(0);
            }
        int wr = wr_, wc = wc_, fr = fr_, fq = fq_;
        asm volatile("" : "+v"(fr), "+v"(fq));
        asm volatile("" : "+s"(wr), "+s"(wc));
        const int colA = 128 * u.pn + 32 * wc + 8 * fq;
#pragma unroll
        for (int ai = 0; ai < 2; ++ai)
#pragma unroll
            for (int m = 0; m < 4; ++m) {
                const int R = 128 * ai + 64 * wr + 16 * m + fr, grow = 254 * u.pm + R - 2;
                u32x4 w;
#pragma unroll
                for (int n = 0; n < 2; ++n) { const f32x4 ca = acc[ai][0][m][n], cg = acc[ai][1][m][n]; f32x4 r;
#pragma unroll
                    for (int c = 0; c < 4; ++c) r[c] = ca[c] * __builtin_amdgcn_rcpf(1.f + __expf(-ca[c])) * cg[c];
                    if (n == 0) { w.x = cvtpk(r[0], r[1]); w.y = cvtpk(r[2], r[3]); } else { w.z = cvtpk(r[0], r[1]); w.w = cvtpk(r[2], r[3]); } }
                if (R >= 2 && grow < MT) __builtin_nontemporal_store(w, (u32x4*)(ACT + (size_t)grow * DFF + colA));
            }
    }
};
}
#define XB_TMO      128
#define XB_XCNT(j)  (256  + 64 * (j))
#define XB_XSUB(j)  (1280 + 64 * (j))
#define XB_XGEN(j)  (2304 + 64 * (j))
#define XB_TOP      3328
#define XB_TOPGEN   3392
#define XCD_BAR_WORDS 3456
#define XB_SPIN_CAP (1u << 23)
__device__ __forceinline__ unsigned xb_ld(unsigned* p)              { return __hip_atomic_load(p, __ATOMIC_RELAXED, __HIP_MEMORY_SCOPE_AGENT); }
__device__ __forceinline__ unsigned xb_add(unsigned* p, unsigned v) { return __hip_atomic_fetch_add(p, v, __ATOMIC_RELAXED, __HIP_MEMORY_SCOPE_AGENT); }
__device__ __forceinline__ unsigned xb_xcc_id() { return (unsigned)__builtin_amdgcn_s_getreg((3 << 11) | 20) & 0xFu; }
#define XB_SPIN(cond, bar) do { unsigned _sp = 0; while (cond) { __builtin_amdgcn_s_sleep(1); \
    if ((++_sp & 255u) == 0u) { if (xb_ld(&(bar)[XB_TMO])) break; if (_sp > XB_SPIN_CAP) { atomicAdd(&(bar)[XB_TMO], 1u); break; } } } } while (0)
struct XcdBarrier { unsigned* bar; unsigned x; volatile LAS unsigned* st; };
__device__ __forceinline__ XcdBarrier xcd_barrier_post(unsigned* bar, volatile LAS unsigned* st) {
    XcdBarrier b; b.bar = bar; b.x = xb_xcc_id(); b.st = st;
    if (threadIdx.x == 0) (void)xb_add(&bar[XB_XCNT(b.x)], 1u);
    return b;
}
__device__ __forceinline__ void xcd_barrier_complete(unsigned* bar, unsigned x, unsigned& nloc, unsigned& nx) {
    const unsigned G = gridDim.x * gridDim.y * gridDim.z;
    unsigned sum, cnt, mine, sp = 0u;
    for (;;) {
        sum = 0u; cnt = 0u; mine = 0u;
#pragma unroll
        for (unsigned j = 0; j < 16; ++j) { const unsigned c = xb_ld(&bar[XB_XCNT(j)]); sum += c; cnt += (c > 0u) ? 1u : 0u; mine = (j == x) ? c : mine; }
        if (sum == G) break;
        __builtin_amdgcn_s_sleep(1);
        if ((++sp & 255u) == 0u) { if (xb_ld(&bar[XB_TMO])) break; if (sp > XB_SPIN_CAP) { atomicAdd(&bar[XB_TMO], 1u); break; } }
    }
    nloc = mine > 0u ? mine : 1u; nx = cnt > 0u ? cnt : 1u;
}
__device__ __forceinline__ void xcd_barrier(const XcdBarrier& b) {
    asm volatile("s_waitcnt vmcnt(0)" ::: "memory");
    __syncthreads();
    if (threadIdx.x == 0) {
        unsigned* bar = b.bar;
        __builtin_amdgcn_s_waitcnt(0);
        unsigned nloc = b.st[0], nx = b.st[1];
        if (nloc == 0u) { xcd_barrier_complete(bar, b.x, nloc, nx); b.st[0] = nloc; b.st[1] = nx; }
        const unsigned old = xb_add(&bar[XB_XSUB(b.x)], 1u);
        const unsigned gen = old / nloc;
        if (old + 1u == (gen + 1u) * nloc) {
            __builtin_amdgcn_fence(__ATOMIC_RELEASE, "agent");
            asm volatile("s_waitcnt vmcnt(0)" ::: "memory");
            const unsigned og = xb_add(&bar[XB_TOP], 1u);
            const unsigned tg = og / nx;
            if (og + 1u == (tg + 1u) * nx) xb_add(&bar[XB_TOPGEN], 1u);
            else XB_SPIN(xb_ld(&bar[XB_TOPGEN]) == tg, bar);
            __builtin_amdgcn_fence(__ATOMIC_ACQUIRE, "agent");
            xb_add(&bar[XB_XGEN(b.x)], 1u);
            asm volatile("s_waitcnt vmcnt(0)" ::: "memory");
        } else {
            XB_SPIN(xb_ld(&bar[XB_XGEN(b.x)]) == gen, bar);
            __builtin_amdgcn_fence(__ATOMIC_ACQUIRE, "agent");
            asm volatile("s_waitcnt vmcnt(0)" ::: "memory");
        }
    }
    __syncthreads();
}

struct MapIn  { __device__ __forceinline__ int operator()(int c) const { if (c < 1024) return c; if (c < 1088) { const int i = c - 1024; return 4096 + 2 * (i & 31) + (i >> 5); } return c - 64; } };
struct MapUq  { __device__ __forceinline__ int operator()(int c) const { const int hd = c / 192, j = c - hd * 192; if (j < 128) return c; const int i = j - 128; return hd * 192 + 128 + 2 * (i & 31) + (i >> 5); } };
struct MapOff { int off; __device__ __forceinline__ int operator()(int c) const { return c + off; } };
struct MapUp  { __device__ __forceinline__ int operator()(int c) const { if (c < DFF) return 256 * (c >> 7) + (c & 127); const int d = c - DFF; return 256 * (d >> 7) + 128 + (d & 127); } };

template <class MAP>
__device__ __forceinline__ void transpose_item(const float* W, int K, int N, bf16_t* WT, LAS float* scr, int item, int lane, MAP map, const float* gk = nullptr) {
    const int nblk = N / 32, kb = item / nblk, nb = item - kb * nblk, k0 = 64 * kb, n0 = 32 * nb;
    float tv[32];
#pragma unroll
    for (int i = 0; i < 32; ++i) { const int kk = 2 * i + (lane >> 5); tv[i] = __builtin_nontemporal_load(W + (size_t)(k0 + kk) * N + n0 + (lane & 31)); }
#pragma unroll
    for (int i = 0; i < 32; ++i) { const int kk = 2 * i + (lane >> 5); scr[kk * 33 + (lane & 31)] = tv[i]; }
    LDS_WAIT(); asm volatile("" ::: "memory");
    const int c = lane & 7;
    f32x4 g0 = {1.f, 1.f, 1.f, 1.f}, g1 = g0;
    if (gk) { g0 = *(const f32x4*)(gk + k0 + 8 * c); g1 = *(const f32x4*)(gk + k0 + 8 * c + 4); }
#pragma unroll
    for (int j = 0; j < 4; ++j) { const int n = (lane >> 3) + 8 * j; const LAS float* s = scr + (8 * c) * 33 + n;
        u32x4 o; o.x = cvtpk(s[0 * 33] * g0[0], s[1 * 33] * g0[1]); o.y = cvtpk(s[2 * 33] * g0[2], s[3 * 33] * g0[3]); o.z = cvtpk(s[4 * 33] * g1[0], s[5 * 33] * g1[1]); o.w = cvtpk(s[6 * 33] * g1[2], s[7 * 33] * g1[3]);
        *(u32x4*)(WT + (size_t)map(n0 + n) * K + k0 + 8 * c) = o; }
    LDS_WAIT(); asm volatile("" ::: "memory");
}

__device__ __forceinline__ void prep_row_f32(const float* xrow, bf16_t* orow, float* ssq, int lane) {
    const f32x4* xr = (const f32x4*)xrow + lane;
    f32x4 v[8]; float s = 0.f;
#pragma unroll
    for (int j = 0; j < 8; ++j) v[j] = __builtin_nontemporal_load(xr + 64 * j);
#pragma unroll
    for (int j = 0; j < 8; ++j) s += (v[j][0] * v[j][0] + v[j][1] * v[j][1]) + (v[j][2] * v[j][2] + v[j][3] * v[j][3]);
    s = wave_sum(s);
    if (lane == 0) *ssq = s;
    u32x2* o8 = (u32x2*)orow + lane;
#pragma unroll
    for (int j = 0; j < 8; ++j) { u32x2 w; w.x = cvtpk(v[j][0], v[j][1]); w.y = cvtpk(v[j][2], v[j][3]); o8[64 * j] = w; }
}
__device__ __forceinline__ void prep_row_bf(bf16_t* xrow, float* ssq, int lane, const float* part, int np, size_t pstride) {
    u32x2* xr = (u32x2*)xrow + lane;
    f32x4 v[8]; float s = 0.f;
#pragma unroll
    for (int j = 0; j < 8; ++j) { const u32x2 b = xr[64 * j]; v[j] = (f32x4){bf_lo(b.x), bf_hi(b.x), bf_lo(b.y), bf_hi(b.y)}; }
    for (int sl = 0; sl < np; ++sl) { const f32x4* pr = (const f32x4*)(part + (size_t)sl * pstride) + lane;
#pragma unroll
        for (int j = 0; j < 8; ++j) v[j] += pr[64 * j]; }
#pragma unroll
    for (int j = 0; j < 8; ++j) s += (v[j][0] * v[j][0] + v[j][1] * v[j][1]) + (v[j][2] * v[j][2] + v[j][3] * v[j][3]);
    s = wave_sum(s);
    if (lane == 0) *ssq = s;
#pragma unroll
    for (int j = 0; j < 8; ++j) { u32x2 w; w.x = cvtpk(v[j][0], v[j][1]); w.y = cvtpk(v[j][2], v[j][3]); xr[64 * j] = w; }
}
__device__ __forceinline__ void final_row(const bf16_t* xrow, float* yrow, const float* g, int lane, const float* ssq, const float* part = nullptr, int np = 0, size_t pstride = 0) {
    const u32x2* xr = (const u32x2*)xrow + lane; const f32x4* gr = (const f32x4*)g + lane; f32x4* yr = (f32x4*)yrow + lane;
    f32x4 v[8]; float s = 0.f;
#pragma unroll
    for (int j = 0; j < 8; ++j) { const u32x2 b = xr[64 * j]; v[j] = (f32x4){bf_lo(b.x), bf_hi(b.x), bf_lo(b.y), bf_hi(b.y)}; }
    for (int sl = 0; sl < np; ++sl) { const f32x4* pr = (const f32x4*)(part + (size_t)sl * pstride) + lane;
#pragma unroll
        for (int j = 0; j < 8; ++j) v[j] += pr[64 * j]; }
    if (ssq) s = wave_sum(lane < 32 ? ssq[lane] : 0.f);
    else {
#pragma unroll
        for (int j = 0; j < 8; ++j) s += (v[j][0] * v[j][0] + v[j][1] * v[j][1]) + (v[j][2] * v[j][2] + v[j][3] * v[j][3]);
        s = wave_sum(s);
    }
    const float rstd = 1.0f / sqrtf(s * (1.f / DM) + EPS);
#pragma unroll
    for (int j = 0; j < 8; ++j) { const f32x4 gg = gr[64 * j]; __builtin_nontemporal_store(v[j] * rstd * gg, yr + 64 * j); }
}
__device__ __forceinline__ void cvt_row512(const float* src, bf16_t* dst, int lane) {
    const f32x4 a = __builtin_nontemporal_load((const f32x4*)src + 2 * lane), b = __builtin_nontemporal_load((const f32x4*)src + 2 * lane + 1);
    u32x4 w; w.x = cvtpk(a[0], a[1]); w.y = cvtpk(a[2], a[3]); w.z = cvtpk(b[0], b[1]); w.w = cvtpk(b[2], b[3]);
    *((u32x4*)dst + lane) = w;
}
__device__ __forceinline__ void norm_row512(bf16_t* row, const float* g, float* fout, int lane) {
    const u32x4 r = *((const u32x4*)row + lane);
    float v[8] = {bf_lo(r.x), bf_hi(r.x), bf_lo(r.y), bf_hi(r.y), bf_lo(r.z), bf_hi(r.z), bf_lo(r.w), bf_hi(r.w)};
    float s = 0.f;
#pragma unroll
    for (int i = 0; i < 8; ++i) s += v[i] * v[i];
    const float rstd = 1.0f / sqrtf(wave_sum(s) * (1.f / 512.f) + EPS);
    const f32x4 g0 = *((const f32x4*)g + 2 * lane), g1 = *((const f32x4*)g + 2 * lane + 1);
    f32x4 o0, o1;
#pragma unroll
    for (int i = 0; i < 4; ++i) { o0[i] = v[i] * rstd * g0[i]; o1[i] = v[4 + i] * rstd * g1[i]; }
    u32x4 w; w.x = cvtpk(o0[0], o0[1]); w.y = cvtpk(o0[2], o0[3]); w.z = cvtpk(o1[0], o1[1]); w.w = cvtpk(o1[2], o1[3]);
    *((u32x4*)row + lane) = w;
    if (fout) { *((f32x4*)fout + 2 * lane) = o0; *((f32x4*)fout + 2 * lane + 1) = o1; }
}

__device__ __forceinline__ void kmax_row(const float (&v)[8], int stream, LAS unsigned* kml, int lane) {
    float s = 0.f;
#pragma unroll
    for (int i = 0; i < 8; ++i) s += v[i] * v[i];
    s += __shfl_xor(s, 1); s += __shfl_xor(s, 2); s += __shfl_xor(s, 4); s += __shfl_xor(s, 8);
    if ((lane & 15) == 0) __hip_atomic_fetch_max(kml + stream * 4 + (lane >> 4), __float_as_uint(s), __ATOMIC_RELAXED, __HIP_MEMORY_SCOPE_WORKGROUP);
}
__device__ __forceinline__ void cvt_row512_kmax(const float* src, bf16_t* dst, int lane, int stream, LAS unsigned* kml) {
    const f32x4 a = __builtin_nontemporal_load((const f32x4*)src + 2 * lane), b = __builtin_nontemporal_load((const f32x4*)src + 2 * lane + 1);
    u32x4 w; w.x = cvtpk(a[0], a[1]); w.y = cvtpk(a[2], a[3]); w.z = cvtpk(b[0], b[1]); w.w = cvtpk(b[2], b[3]);
    *((u32x4*)dst + lane) = w;
    const float v[8] = {bf_lo(w.x), bf_hi(w.x), bf_lo(w.y), bf_hi(w.y), bf_lo(w.z), bf_hi(w.z), bf_lo(w.w), bf_hi(w.w)};
    kmax_row(v, stream, kml, lane);
}
__device__ __forceinline__ void kmax_flush(LAS unsigned* kml, unsigned* gk, int tid) {
    __syncthreads();
    if (tid < 40) { const unsigned v = kml[tid]; if (v) __hip_atomic_fetch_max(gk + tid, v, __ATOMIC_RELAXED, __HIP_MEMORY_SCOPE_AGENT); kml[tid] = 0u; }
    __syncthreads();
}

__device__ __forceinline__ void norm512_regs(const u32x4 r, const f32x4 g0, const f32x4 g1, bf16_t* row, float* fout, int lane) {
    float v[8] = {bf_lo(r.x), bf_hi(r.x), bf_lo(r.y), bf_hi(r.y), bf_lo(r.z), bf_hi(r.z), bf_lo(r.w), bf_hi(r.w)};
    float s = 0.f;
#pragma unroll
    for (int i = 0; i < 8; ++i) s += v[i] * v[i];
    const float rstd = 1.0f / sqrtf(wave_sum(s) * (1.f / 512.f) + EPS);
    f32x4 o0, o1;
#pragma unroll
    for (int i = 0; i < 4; ++i) { o0[i] = v[i] * rstd * g0[i]; o1[i] = v[4 + i] * rstd * g1[i]; }
    u32x4 w; w.x = cvtpk(o0[0], o0[1]); w.y = cvtpk(o0[2], o0[3]); w.z = cvtpk(o1[0], o1[1]); w.w = cvtpk(o1[2], o1[3]);
    *((u32x4*)row + lane) = w;
    if (fout) { __builtin_nontemporal_store(o0, (f32x4*)fout + 2 * lane); __builtin_nontemporal_store(o1, (f32x4*)fout + 2 * lane + 1); }
}

__device__ __forceinline__ void ssq_reduce(const float* ssp, float* ssq, int t0, int stride) {
    for (int r = t0; r < MP; r += stride) { const f32x4* p = (const f32x4*)(ssp + (size_t)r * 32); float s = 0.f;
#pragma unroll
        for (int j = 0; j < 8; ++j) { const f32x4 v = p[j]; s += (v[0] + v[1]) + (v[2] + v[3]); }
        ssq[r] = s; }
}
namespace att {
typedef short v4i16_t __attribute__((ext_vector_type(4)));
#ifndef SM_THR
#define SM_THR 8.0f
#endif
constexpr int IMG_K = 0, IMG_V = 16384, IMG_R = 32768, SLOT_BYTES = 40960, NSLOT = 3;
constexpr int OFF_BIAS = NSLOT * SLOT_BYTES, OFF_SLOT = OFF_BIAS + 1040, OFF_DONE = OFF_SLOT + 16, STAGE_ROWB = 272, STAGE_WAVE = 32 * STAGE_ROWB;
static_assert(8 * STAGE_WAVE <= OFF_BIAS && OFF_DONE + 32 <= RING_BYTES, "attention LDS map");
struct Tens { const bf16_t* Q; int qpitch; const bf16_t* K; const bf16_t* KR; const bf16_t* V; bf16_t* HEADS; const float* gh; const float* bias; };
__device__ __forceinline__ s16x4 vtr(const LAS unsigned char* p) { return __builtin_bit_cast(s16x4, __builtin_amdgcn_ds_read_tr16_b64_v4i16((LAS v4i16_t*)p)); }
#define ATT_MFMA(a, b, c) __builtin_amdgcn_mfma_f32_32x32x16_bf16((a), (b), (c), 0, 0, 0)
#define ATT_BAR() do { asm volatile("s_waitcnt lgkmcnt(0)" ::: "memory"); __builtin_amdgcn_s_barrier(); asm volatile("" ::: "memory"); } while (0)

template <int VAR>
__device__ __forceinline__ void attn_unit(LAS unsigned char* lds, const Tens& T, int head, int qrow0, int nw, int krow0, int qrel0, float kmax2) {
    constexpr int DQK = VAR == 0 ? 192 : 128, KS = DQK / 16;
    const int tid = fresh_tid(), w = __builtin_amdgcn_readfirstlane(tid >> 6), lane = tid & 63, r = lane & 31, h = lane >> 5;
    const bool active = w < nw;
    const int qw = qrel0 + 32 * w;
    int t_lo = 0, t_hi;
    if (VAR == 0) t_hi = (qrel0 + 32 * (nw - 1)) >> 6;
    else if (VAR == 1) { t_lo = (qrel0 >> 6) - 8; if (t_lo < 0) t_lo = 0; t_hi = (qrel0 + 32 * (nw - 1)) >> 6; }
    else t_hi = (qrel0 + 32 * (nw - 1) + 30) >> 6;
    const int nt = t_hi - t_lo + 1;
    bf16x8 qf[KS];
    { const bf16_t* qp = T.Q + (size_t)(qrow0 + 32 * (active ? w : 0) + r) * T.qpitch + head * DQK + 8 * h;
#pragma unroll
      for (int ds = 0; ds < KS; ++ds) qf[ds] = *(const bf16x8*)(qp + 16 * ds); }
    unsigned oK[2];
#pragma unroll
    for (int i = 0; i < 2; ++i) { const int p = 64 * (w + 8 * i) + lane, row = p >> 4, pos = p & 15, ch = pos ^ (((row & 3) << 2) | ((row >> 2) & 3));
        oK[i] = (unsigned)(((krow0 + row) * 512 + 128 * head + 8 * ch) * 2); }
    unsigned oR = 0;
    if (VAR == 0) { const int p = 64 * w + lane, row = p >> 3, pos = p & 7, ch = pos ^ ((row >> 1) & 7); oR = (unsigned)(((krow0 + row) * 64 + 8 * ch) * 2); }
    const char* gKb = (const char*)T.K; const char* gVb = (const char*)T.V; const char* gRb = (const char*)T.KR;
#define ATT_DMA(kt_, slot_) do { LAS unsigned char* sb_ = lds + (slot_) * SLOT_BYTES + w * 1024; \
        _Pragma("unroll") for (int i_ = 0; i_ < 2; ++i_) { \
            __builtin_amdgcn_global_load_lds((const unsigned*)(gKb + (size_t)(kt_) * 65536 + oK[i_]), (LAS unsigned*)(sb_ + IMG_K + i_ * 8192), 16, 0, 0); \
            __builtin_amdgcn_global_load_lds((const unsigned*)(gVb + (size_t)(kt_) * 65536 + oK[i_]), (LAS unsigned*)(sb_ + IMG_V + i_ * 8192), 16, 0, 0); } \
        if (VAR == 0) __builtin_amdgcn_global_load_lds((const unsigned*)(gRb + (size_t)(kt_) * 8192 + oR), (LAS unsigned*)(sb_ + IMG_R), 16, 0, 0); } while (0)
#define ATT_WAIT_TILE(more_) do { if (more_) { if (VAR == 0) asm volatile("s_waitcnt vmcnt(5)" ::: "memory"); else asm volatile("s_waitcnt vmcnt(4)" ::: "memory"); } else asm volatile("s_waitcnt vmcnt(0)" ::: "memory"); } while (0)
#define ATT_TILE(i_) ((VAR == 2) ? (t_hi - (i_)) : (t_lo + (i_)))
    if (VAR == 1) { LAS float* bl = (LAS float*)(lds + OFF_BIAS); if (tid < 257) bl[tid] = T.bias[tid] * LOG2E; }
    volatile LAS int* doneit = (volatile LAS int*)(lds + OFF_DONE);
    float zb = 0.f;
    if (VAR == 2) {
        if (tid < 8) doneit[tid] = (tid < nw) ? 0x7fffffff : -1;
        float qs = 0.f;
#pragma unroll
        for (int ds = 0; ds < KS; ++ds)
#pragma unroll
            for (int e = 0; e < 8; ++e) { const float qv = __uint_as_float(((unsigned)(unsigned short)qf[ds][e]) << 16); qs += qv * qv; }
        qs += __shfl_xor(qs, 32);
        zb = sqrtf(qs * kmax2) * 1.02f + 1.0f;
    }
    bool wdone = false;
    asm volatile("s_waitcnt vmcnt(0)" ::: "memory");
    ATT_DMA(ATT_TILE(0), 0); if (nt > 1) ATT_DMA(ATT_TILE(1), 1);
    ATT_WAIT_TILE(nt > 1); ATT_BAR();
    f32x16 o[4];
#pragma unroll
    for (int d = 0; d < 4; ++d)
#pragma unroll
        for (int i = 0; i < 16; ++i) o[d][i] = 0.f;
    float m_run = 0.f, l_run = 0.f, carry = 0.f; bool first = true;
    const int i16 = lane & 15, q4 = i16 >> 2, p4 = i16 & 3, blk = (lane >> 4) & 1;
    const int swl = ((r & 3) << 2) | ((r >> 2) & 3);
    const int krow = IMG_K + 256 * r, rrow = IMG_R + 128 * r, rsw = (r >> 1) & 7;
    const int vlow = 2 * blk + (p4 >> 1);
    const int vb0 = IMG_V + 256 * (4 * h + q4) + 16 * (vlow ^ (h & 3)) + 8 * (p4 & 1);
    const int vb1 = IMG_V + 256 * (4 * h + q4 + 8) + 16 * (vlow ^ ((h + 2) & 3)) + 8 * (p4 & 1);
    u32x4 pk[4];
#define ATT_PV(sl_) do { const LAS unsigned char* vs_ = (sl_); \
        _Pragma("unroll") for (int ks_ = 0; ks_ < 4; ++ks_) { const bf16x8 pf_ = __builtin_bit_cast(bf16x8, pk[ks_]); \
            _Pragma("unroll") for (int db_ = 0; db_ < 4; ++db_) { const int dx_ = ((db_ ^ q4) << 6) + 4096 * ks_; \
                const s16x4 lo_ = vtr(vs_ + vb0 + dx_), hi_ = vtr(vs_ + vb1 + dx_); const bf16x8 vf_ = __builtin_shufflevector(lo_, hi_, 0, 1, 2, 3, 4, 5, 6, 7); o[db_] = ATT_MFMA(vf_, pf_, o[db_]); } \
            asm volatile("" ::: "memory"); } } while (0)
    int slot = 0;
    for (int it = 0; it < nt; ++it) {
        if (VAR == 2 && it > 0) { int c = 0;
#pragma unroll
            for (int j = 0; j < 8; ++j) c += (doneit[j] < it) ? 1 : 0;
            if (c == 8) break; }
        const bool more2 = it + 2 < nt;
        { int s2 = slot + 2; if (s2 >= NSLOT) s2 -= NSLOT; if (more2) ATT_DMA(ATT_TILE(it + 2), s2); }
        const int kt = ATT_TILE(it);
        const LAS unsigned char* sl = lds + slot * SLOT_BYTES;
        bool vis;
        if (VAR == 0) vis = kt <= (qw >> 6);
        else if (VAR == 1) vis = kt <= (qw >> 6) && kt >= (qw >> 6) - 8;
        else vis = 64 * kt <= qw + 30;
        if (active && vis && !wdone) {
            f32x16 x0, x1;
#pragma unroll
            for (int i = 0; i < 16; ++i) { x0[i] = 0.f; x1[i] = 0.f; }
            {
                bf16x8 ke0[4], ke1[4], kf0[4], kf1[4];
#define ATT_KLOAD(a0_, a1_, g_) do { _Pragma("unroll") for (int j_ = 0; j_ < 4; ++j_) { const int ds_ = 4 * (g_) + j_; \
                    const LAS unsigned char* ka_ = (ds_ < 8) ? sl + krow + 16 * ((2 * ds_ + h) ^ swl) : sl + rrow + 16 * ((2 * (ds_ - 8) + h) ^ rsw); \
                    const int kstep_ = (ds_ < 8) ? 32 * 256 : 32 * 128;                                         \
                    a0_[j_] = *(const LAS bf16x8*)(ka_); a1_[j_] = *(const LAS bf16x8*)(ka_ + kstep_); } } while (0)
                ATT_KLOAD(ke0, ke1, 0);
                __builtin_amdgcn_sched_barrier(0);
#pragma unroll
                for (int g = 0; g < KS / 4; ++g) {
                    if (g + 1 < KS / 4) { if (g & 1) ATT_KLOAD(ke0, ke1, g + 1); else ATT_KLOAD(kf0, kf1, g + 1); }
#pragma unroll
                    for (int j = 0; j < 4; ++j) { const int ds = 4 * g + j;
                        if (g & 1) { x0 = ATT_MFMA(kf0[j], qf[ds], x0); x1 = ATT_MFMA(kf1[j], qf[ds], x1); } else { x0 = ATT_MFMA(ke0[j], qf[ds], x0); x1 = ATT_MFMA(ke1[j], qf[ds], x1); } }
                    __builtin_amdgcn_sched_barrier(0);
                }
#undef ATT_KLOAD
            }
            if (VAR != 2) {
                if (VAR == 1) {
                    const LAS float* bl = (const LAS float*)(lds + OFF_BIAS);
                    if (qw - (64 * kt + 63) >= 128) { const float bc = bl[256];
#pragma unroll
                        for (int i = 0; i < 16; ++i) { x0[i] += bc; x1[i] += bc; } }
                    else { const int dq = qw + r - 64 * kt - 4 * h + 128;
#pragma unroll
                        for (int i = 0; i < 16; ++i) { int d0 = dq - ((i & 3) + 8 * (i >> 2)); int d1 = d0 - 32;
                            d0 = d0 < 0 ? 0 : (d0 > 256 ? 256 : d0); d1 = d1 < 0 ? 0 : (d1 > 256 ? 256 : d1); x0[i] += bl[d0]; x1[i] += bl[d1]; } }
                }
                float mx = x0[0];
#pragma unroll
                for (int i = 1; i < 16; ++i) mx = fmaxf(mx, x0[i]);
#pragma unroll
                for (int i = 0; i < 16; ++i) mx = fmaxf(mx, x1[i]);
                mx = fmaxf(mx, __shfl_xor(mx, 32)) - m_run;
                float ps = 0.f;
                const float dlt = first ? mx : (mx > SM_THR ? mx : 0.f);
                const bool moved = __any(first || mx > SM_THR);
                first = false;
                m_run += dlt;
#pragma unroll
                for (int i = 0; i < 16; ++i) { x0[i] = __builtin_amdgcn_exp2f(x0[i] - m_run); x1[i] = __builtin_amdgcn_exp2f(x1[i] - m_run); ps += x0[i] + x1[i]; }
                if (moved) {
                    const float alpha = __builtin_amdgcn_exp2f(-dlt);
                    l_run *= alpha;
#pragma unroll
                    for (int d = 0; d < 4; ++d)
#pragma unroll
                        for (int i = 0; i < 16; ++i) o[d][i] *= alpha;
                }
                l_run += ps;
            } else {
                const int q = qw + r, kbase = 64 * kt + 4 * h;
                const bool diag = (64 * kt + 63 >= qw);
                float tot = 0.f;
#pragma unroll
                for (int kbi = 1; kbi >= 0; --kbi) {
#pragma unroll
                    for (int g = 3; g >= 0; --g) {
                        float zz[4], lk[4]; bool vl[4];
#pragma unroll
                        for (int jj = 0; jj < 4; ++jj) { const int i = 4 * g + jj; zz[jj] = kbi ? x1[i] : x0[i]; vl[jj] = !diag || (kbase + 32 * kbi + 8 * g + jj) < q;
                            const float sp = fmaxf(zz[jj], 0.f) + __builtin_amdgcn_logf(1.f + __builtin_amdgcn_exp2f(-fabsf(zz[jj])));
                            lk[jj] = vl[jj] ? -sp : 0.f; }
                        const float s3 = lk[3], s2 = lk[2] + s3, s1 = lk[1] + s2, s0 = lk[0] + s1;
                        const float tp = __shfl_xor(s0, 32);
                        const float base = carry + tot + (h == 0 ? tp : 0.f);
                        const float sx[4] = {s0, s1, s2, s3};
#pragma unroll
                        for (int jj = 0; jj < 4; ++jj) { const int i = 4 * g + jj; const float wv = vl[jj] ? __builtin_amdgcn_exp2f(zz[jj] + sx[jj] + base) : 0.f; if (kbi) x1[i] = wv; else x0[i] = wv; }
                        tot += s0 + tp;
                    }
                }
                carry += tot;
                if (__all(zb + carry < -150.f)) { wdone = true; if (lane == 0) doneit[w] = it; }
            }
            __builtin_amdgcn_sched_barrier(0);
#pragma unroll
            for (int s2 = 0; s2 < 2; ++s2) {
                pk[s2].x = cvtpk(x0[8 * s2 + 0], x0[8 * s2 + 1]); pk[s2].y = cvtpk(x0[8 * s2 + 2], x0[8 * s2 + 3]); pk[s2].z = cvtpk(x0[8 * s2 + 4], x0[8 * s2 + 5]); pk[s2].w = cvtpk(x0[8 * s2 + 6], x0[8 * s2 + 7]);
                pk[2 + s2].x = cvtpk(x1[8 * s2 + 0], x1[8 * s2 + 1]); pk[2 + s2].y = cvtpk(x1[8 * s2 + 2], x1[8 * s2 + 3]); pk[2 + s2].z = cvtpk(x1[8 * s2 + 4], x1[8 * s2 + 5]); pk[2 + s2].w = cvtpk(x1[8 * s2 + 6], x1[8 * s2 + 7]);
            }
            ATT_PV(sl);
        }
        ATT_WAIT_TILE(more2);
        ATT_BAR();
        if (++slot == NSLOT) slot = 0;
    }
    asm volatile("s_waitcnt vmcnt(0)" ::: "memory"); ATT_BAR();
#undef ATT_PV
    if (active) {
        float inv = 1.f;
        if (VAR != 2) { const float l = l_run + __shfl_xor(l_run, 32); inv = 1.f / l; }
        float ss = 0.f;
#pragma unroll
        for (int d = 0; d < 4; ++d)
#pragma unroll
            for (int i = 0; i < 16; ++i) { o[d][i] *= inv; ss += o[d][i] * o[d][i]; }
        ss += __shfl_xor(ss, 32);
        const float rstd = 1.0f / sqrtf(ss * (1.f / 128.f) + EPS);
        LAS unsigned char* st = lds + w * STAGE_WAVE;
#pragma unroll
        for (int d = 0; d < 4; ++d)
#pragma unroll
            for (int g = 0; g < 4; ++g) { const int d0 = 32 * d + 8 * g + 4 * h; const f32x4 gv = *(const f32x4*)(T.gh + d0);
                u32x2 pkk; pkk.x = cvtpk(o[d][4 * g] * rstd * gv[0], o[d][4 * g + 1] * rstd * gv[1]); pkk.y = cvtpk(o[d][4 * g + 2] * rstd * gv[2], o[d][4 * g + 3] * rstd * gv[3]);
                *(LAS u32x2*)(st + r * STAGE_ROWB + d0 * 2) = pkk; }
        LDS_WAIT(); asm volatile("" ::: "memory");
#pragma unroll
        for (int j = 0; j < 8; ++j) { const int c = lane + 64 * j, row = c >> 4, cc = c & 15;
            const u32x4 v = *(const LAS u32x4*)(st + row * STAGE_ROWB + cc * 16);
            *(u32x4*)(T.HEADS + (size_t)(qrow0 + 32 * w + row) * NMIX + (VAR * 4 + head) * 128 + cc * 8) = v; }
    }
#undef ATT_DMA
#undef ATT_WAIT_TILE
#undef ATT_TILE
}

template <int VAR>
__device__ __forceinline__ void attn_queue(LAS unsigned char* lds, const Tens& T, unsigned* ctr8, int xcc, const float* gheads, const float* relbias, const unsigned* kmaxw) {
    volatile LAS unsigned* slot = (volatile LAS unsigned*)(lds + OFF_SLOT);
    for (;;) {
        __syncthreads();
        if (threadIdx.x == 0) {
            unsigned got = 0xffffffffu;
            for (int qi = 0; qi < 8; ++qi) { const int list = (xcc + qi) & 7;
                if (__hip_atomic_load(ctr8 + list * 64, __ATOMIC_RELAXED, __HIP_MEMORY_SCOPE_AGENT) >= 68u) continue;
                const unsigned u = __hip_atomic_fetch_add(ctr8 + list * 64, 1u, __ATOMIC_RELAXED, __HIP_MEMORY_SCOPE_AGENT);
                if (u < 68u) { got = ((unsigned)list << 8) | u; break; } }
            *slot = got;
        }
        __syncthreads();
        const unsigned g = (unsigned)__builtin_amdgcn_readfirstlane((int)*slot);
        if (g == 0xffffffffu) break;
        const int list = (int)(g >> 8), u = (int)(g & 255u);
        int head, qrow0, nw, krow0, qrel0, stream;
        if (u < 64) { const int qb = 63 - u, b = list >> 2; head = list & 3; qrow0 = b * SEQ + 256 * qb; nw = 8; krow0 = b * SEQ; qrel0 = 256 * qb; stream = b; }
        else { const int j = list * 4 + (u - 64), b = j >> 2; head = j & 3; qrow0 = MP + 64 * b; nw = 2; krow0 = MP + b * (VAR == 1 ? BSTR : CSTR); qrel0 = (VAR == 1) ? 512 : PAST; stream = 2 + b; }
        Tens t = T; t.gh = gheads + (VAR * 4 + head) * 128; t.bias = relbias + head * 257;
        float kmax2 = 0.f;
        if (VAR == 2) kmax2 = __uint_as_float(__hip_atomic_load(kmaxw + stream * 4 + head, __ATOMIC_RELAXED, __HIP_MEMORY_SCOPE_AGENT));
        attn_unit<VAR>(lds, t, head, qrow0, nw, krow0, qrel0, kmax2);
    }
}
}
__constant__ float c_inv_freq[32] = {1.000000000e+00f, 7.498942614e-01f, 5.623413324e-01f, 4.216965139e-01f, 3.162277639e-01f, 2.371373773e-01f, 1.778279394e-01f, 1.333521307e-01f,
    1.000000015e-01f, 7.498941571e-02f, 5.623413250e-02f, 4.216965288e-02f, 3.162277490e-02f, 2.371373773e-02f, 1.778279431e-02f, 1.333521493e-02f,
    9.999999776e-03f, 7.498941850e-03f, 5.623413250e-03f, 4.216964822e-03f, 3.162277630e-03f, 2.371373586e-03f, 1.778279431e-03f, 1.333521446e-03f,
    1.000000047e-03f, 7.498942432e-04f, 5.623413017e-04f, 4.216965172e-04f, 3.162277571e-04f, 2.371373703e-04f, 1.778279402e-04f, 1.333521504e-04f};

#ifndef PHASE_MASK
#define PHASE_MASK 0xFFFF
#endif
#ifndef WGM_RES
#define WGM_RES 4
#endif
#ifndef DUP_A
#define DUP_A 0
#endif
#ifndef DUP_UP
#define DUP_UP 0
#endif
#ifndef DUP_IN
#define DUP_IN 0
#endif
#ifndef DUP_W
#define DUP_W 0
#endif
#ifndef DUP_BC
#define DUP_BC 0
#endif
#ifndef DUP_N2
#define DUP_N2 0
#endif
#ifndef FILL_IN
#define FILL_IN 8
#endif
#ifndef FILL_UP
#define FILL_UP 11
#endif
struct Args { const float* in[25]; float* out; unsigned char* ws; };

constexpr int PTAB_OFF = RING_BYTES + 1024;
__device__ __forceinline__ const void* ldptr(volatile LAS unsigned long long* t_, int k) {
    unsigned tb = (unsigned)(size_t)t_; asm volatile("" : "+s"(tb));
    volatile LAS unsigned long long* t = (volatile LAS unsigned long long*)(size_t)tb;
    const unsigned long long v = t[k];
    const unsigned lo = (unsigned)__builtin_amdgcn_readfirstlane((int)(unsigned)v), hi = (unsigned)__builtin_amdgcn_readfirstlane((int)(unsigned)(v >> 32));
    return (const void*)(GAS const unsigned char*)(((unsigned long long)hi << 32) | lo);
}
#define P_IN(k) ((const float*)ldptr(ptab, (k)))
#define P_OUT() ((float*)ldptr(ptab, 25))
#define P_WS() ((unsigned char*)ldptr(ptab, 26))

__global__ void __launch_bounds__(512, 2) fwd_kernel(Args args) {
    extern __shared__ __attribute__((aligned(16))) unsigned char lds_raw[];
    LAS unsigned char* lds = (LAS unsigned char*)lds_raw;
    volatile LAS unsigned* MISC = (volatile LAS unsigned*)(lds + MISC_OFF);
    volatile LAS unsigned long long* ptab = (volatile LAS unsigned long long*)(lds + PTAB_OFF);
    const int tid = threadIdx.x;
    const int G = gridDim.x, NGW = G * 8;
    for (int u = tid; u < (LDS_BYTES - RING_BYTES) / 4; u += 512) ((LAS unsigned*)(lds + RING_BYTES))[u] = 0u;
    __syncthreads();
    if (tid < 25) ptab[tid] = (unsigned long long)args.in[tid];
    if (tid == 25) ptab[25] = (unsigned long long)args.out;
    if (tid == 26) ptab[26] = (unsigned long long)args.ws;
    __syncthreads();
    XcdBarrier bar = xcd_barrier_post((unsigned*)(args.ws + WS_CTL) + CW_BAR, MISC + 8);

    {
        f32x2* ROPE = (f32x2*)(P_WS() + WS_ROPE);
        for (int e = blockIdx.x * 512 + tid; e < SEQ * 32; e += G * 512) {
            const int pos = e >> 5, i = e & 31;
            const float ang = (float)pos * c_inv_freq[i];
            const double rev = (double)ang * 0.15915494309189535; const float fr = (float)(rev - floor(rev));
            ROPE[e] = (f32x2){__builtin_amdgcn_cosf(fr), __builtin_amdgcn_sinf(fr)};
        }
    }

    constexpr int I_IN = 32 * 130, I_UQ = 8 * 24, I_UK = 8 * 16, I_OUT = 24 * 64, I_UP = 32 * 352, I_DN = 88 * 64, I_ALL = I_IN + I_UQ + 2 * I_UK + I_OUT + I_UP + I_DN;
    auto w_items = [&](int lt, int wv, int stride, int lo, int hi) __attribute__((always_inline)) {
        const int tid = fresh_tid(), lane = tid & 63, wave = __builtin_amdgcn_readfirstlane(tid >> 6);
        unsigned char* ws = P_WS() + ((lt & 1) ? WALT : 0);
        LAS float* scr = (LAS float*)(lds + wave * 16384);
        for (int it = lo + wv; it < hi; it += stride) {
            int r = it;
            if (r < I_IN) { transpose_item(P_IN(10) + (size_t)lt * DM * 4160, DM, 4160, (bf16_t*)(ws + WS_WIN), scr, r, lane, MapIn{}, P_IN(9) + (size_t)lt * DM); continue; } r -= I_IN;
            if (r < I_UQ) { transpose_item(P_IN(12) + (size_t)lt * 512 * 768, 512, 768, (bf16_t*)(ws + WS_WUQ), scr, r, lane, MapUq{}); continue; } r -= I_UQ;
            if (r < I_UK) { transpose_item(P_IN(14) + (size_t)lt * 512 * 512, 512, 512, (bf16_t*)(ws + WS_WKV), scr, r, lane, MapOff{0}); continue; } r -= I_UK;
            if (r < I_UK) { transpose_item(P_IN(15) + (size_t)lt * 512 * 512, 512, 512, (bf16_t*)(ws + WS_WKV), scr, r, lane, MapOff{512}); continue; } r -= I_UK;
            if (r < I_OUT) { transpose_item(P_IN(18) + (size_t)lt * NMIX * DM, NMIX, DM, (bf16_t*)(ws + WS_WOUT), scr, r, lane, MapOff{0}); continue; } r -= I_OUT;
            if (r < I_UP) { transpose_item(P_IN(20) + (size_t)lt * DM * NUP, DM, NUP, (bf16_t*)(ws + WS_WUP), scr, r, lane, MapUp{}, P_IN(19) + (size_t)lt * DM); continue; } r -= I_UP;
            transpose_item(P_IN(23) + (size_t)lt * DFF * DM, DFF, DM, (bf16_t*)(ws + WS_WDN), scr, r, lane, MapOff{0});
        }
    };
    const int idle_in = (MT / 256 * (NIN / 256)) % G, idle_up = (132 * (NUP / 256)) % G;
    const int n_in = idle_in ? (G - idle_in) * 8 : 0, n_up = idle_up ? (G - idle_up) * 8 : 0;
    int F1 = n_in * FILL_IN; if (F1 > I_ALL) F1 = I_ALL;
    int F2 = F1 + n_up * FILL_UP; if (F2 > I_ALL) F2 = I_ALL;

    for (int l = 0; l < DEPTH; ++l) {
        if (PHASE_MASK & (1 << 0))
        for (int rep = 0; rep < 1 + DUP_W; ++rep)
        {
            const int tid = fresh_tid(), lane = tid & 63, wave = __builtin_amdgcn_readfirstlane(tid >> 6), gw = blockIdx.x * 8 + wave;
            unsigned char* ws = P_WS();
            w_items(l, gw, NGW, l == 0 ? 0 : F2, I_ALL);
            for (int it = gw; it < 40960; it += NGW) {
                if (it < 8192) { const int b = it >> 10, t = it & 1023; cvt_row512(P_IN(2) + ((size_t)(l * SB + b) * PAST + t) * 512, (bf16_t*)(ws + WS_CKV) + (size_t)(MP + b * CSTR + t) * 512, lane); }
                else if (it < 16384) { const int j = it - 8192, b = j >> 10, t = j & 1023;
                    if (lane < 32) { const float* s = P_IN(3) + ((size_t)(l * SB + b) * PAST + t) * 64; ((unsigned*)((bf16_t*)(ws + WS_KR) + (size_t)(MP + b * CSTR + t) * 64))[lane] = cvtpk(s[lane], s[lane + 32]); } }
                else if (it < 20480) { const int j = it - 16384, b = j >> 9, t = j & 511; cvt_row512(P_IN(4) + ((size_t)(l * SB + b) * 512 + t) * 512, (bf16_t*)(ws + WS_KB) + (size_t)(MP + b * BSTR + t) * 512, lane); }
                else if (it < 24576) { const int j = it - 20480, b = j >> 9, t = j & 511; cvt_row512(P_IN(5) + ((size_t)(l * SB + b) * 512 + t) * 512, (bf16_t*)(ws + WS_VB) + (size_t)(MP + b * BSTR + t) * 512, lane); }
                else if (it < 32768) { const int j = it - 24576, b = j >> 10, t = j & 1023; cvt_row512_kmax(P_IN(6) + ((size_t)(l * SB + b) * PAST + t) * 512, (bf16_t*)(ws + WS_KC) + (size_t)(MP + b * CSTR + t) * 512, lane, 2 + b, (LAS unsigned*)(lds + KMAXL_OFF)); }
                else { const int j = it - 32768, b = j >> 10, t = j & 1023; cvt_row512(P_IN(7) + ((size_t)(l * SB + b) * PAST + t) * 512, (bf16_t*)(ws + WS_VC) + (size_t)(MP + b * CSTR + t) * 512, lane); }
            }
            {
                bf16_t* XB = (bf16_t*)(ws + WS_H); float* ssq = (float*)(ws + WS_SSQ) + (size_t)(l * 2 + 0) * MT;
                if (l == 0) { const float* xp = P_IN(0); const float* xs = P_IN(1);
                    for (int m = gw; m < MT; m += NGW) prep_row_f32(m < MP ? xp + (size_t)m * DM : xs + (size_t)(m - MP) * DM, XB + (size_t)m * DM, ssq + m, lane); }
                else { const float* part = (const float*)(ws + WS_PART);
                    for (int m = MP + gw; m < MT; m += NGW) prep_row_bf(XB + (size_t)m * DM, ssq + m, lane, part + (size_t)(m - MP) * DM, NS_DOWN, (size_t)MS * DM);
                    ssq_reduce((const float*)(ws + WS_SSP), ssq, blockIdx.x * 512 + tid, G * 512); }
            }
            kmax_flush((LAS unsigned*)(lds + KMAXL_OFF), (unsigned*)(ws + WS_CTL) + CW_KMAX + l * 64, tid);
        }
        xcd_barrier(bar);

        if (PHASE_MASK & (1 << 1))
        for (int rep = 0; rep < 1 + DUP_IN; ++rep)
        {
            unsigned char* ws = P_WS();
            pg8::Gemm g{(const bf16_t*)(ws + WS_H), (const bf16_t*)(ws + ((l & 1) ? WALT : 0) + WS_WIN), DM}; pg8::StaticOrder S; S.init(MT / 256, NIN / 256, G, (int)blockIdx.x, DM / 64);
            pg8::EpiIn E{ws, P_OUT(), l, (const float*)(ws + WS_SSQ) + (size_t)(l * 2 + 0) * MT};
            pg8::gemm_phase<pg8::EpiIn, pg8::StaticOrder, 0>(lds, g, S, E);
            if (rep == 0 && l + 1 < DEPTH && idle_in && (int)blockIdx.x >= idle_in) { __syncthreads(); w_items(l + 1, ((int)blockIdx.x - idle_in) * 8 + __builtin_amdgcn_readfirstlane((int)(fresh_tid() >> 6)), n_in, 0, F1); }
        }
        xcd_barrier(bar);

        if (PHASE_MASK & (1 << 2))
        {
            const int tid = fresh_tid(), lane = tid & 63, wave = __builtin_amdgcn_readfirstlane(tid >> 6), gw = blockIdx.x * 8 + wave;
            unsigned char* ws = P_WS(); float* out = P_OUT(); const float* gq = P_IN(11) + (size_t)l * 512; const float* gkv = P_IN(13) + (size_t)l * 512;
            bf16_t *CQ = (bf16_t*)(ws + WS_CQ), *CKV = (bf16_t*)(ws + WS_CKV), *KR = (bf16_t*)(ws + WS_KR); const f32x2* ROPE = (const f32x2*)(ws + WS_ROPE);
            const f32x4 gq0 = *((const f32x4*)gq + 2 * lane), gq1 = *((const f32x4*)gq + 2 * lane + 1), gk0 = *((const f32x4*)gkv + 2 * lane), gk1 = *((const f32x4*)gkv + 2 * lane + 1);
            const bf16_t* KC = (const bf16_t*)(ws + WS_KC);
            for (int m0 = 2 * gw; m0 < MT; m0 += 2 * NGW) {
                u32x4 rq[2], rk[2], rc[2]; unsigned rr[2] = {0u, 0u}; f32x2 cs[2] = {{0.f, 0.f}, {0.f, 0.f}}; int rowc[2];
#pragma unroll
                for (int j = 0; j < 2; ++j) { const int m = m0 + j; rowc[j] = pg8::map_c(m);
                    rq[j] = *((const u32x4*)(CQ + (size_t)m * 512) + lane); rk[j] = *((const u32x4*)(CKV + (size_t)rowc[j] * 512) + lane); rc[j] = *((const u32x4*)(KC + (size_t)rowc[j] * 512) + lane);
                    if (lane < 32) { const int pos = m >= MP ? PAST + ((m - MP) & 63) : (m & (SEQ - 1)); rr[j] = *((const unsigned*)(KR + (size_t)rowc[j] * 64) + lane); cs[j] = ROPE[(size_t)pos * 32 + lane]; } }
#pragma unroll
                for (int j = 0; j < 2; ++j) { const int m = m0 + j; const bool smp = m >= MP; const int ms = m - MP;
                    norm512_regs(rq[j], gq0, gq1, CQ + (size_t)m * 512, nullptr, lane);
                    float* ockv = smp ? out + O_SACKV + ((size_t)l * MS + ms) * 512 : out + O_PACKV + ((size_t)l * MP + m) * 512;
                    norm512_regs(rk[j], gk0, gk1, CKV + (size_t)rowc[j] * 512, ockv, lane);
                    if (lane < 32) {
                        const float x1 = bf_lo(rr[j]), x2 = bf_hi(rr[j]);
                        const float o1 = x1 * cs[j][0] - x2 * cs[j][1], o2 = x1 * cs[j][1] + x2 * cs[j][0];
                        *((unsigned*)(KR + (size_t)rowc[j] * 64) + lane) = cvtpk(o1, o2);
                        float* okr = smp ? out + O_SAKR + ((size_t)l * MS + ms) * 64 : out + O_PAKR + ((size_t)l * MP + m) * 64;
                        okr[lane] = o1; okr[lane + 32] = o2;
                    }
                    {
                        const u32x4 r = rc[j];
                        const float v[8] = {bf_lo(r.x), bf_hi(r.x), bf_lo(r.y), bf_hi(r.y), bf_lo(r.z), bf_hi(r.z), bf_lo(r.w), bf_hi(r.w)};
                        kmax_row(v, smp ? 2 + (ms >> 6) : (m >> 14), (LAS unsigned*)(lds + KMAXL_OFF), lane);
                    }
                }
            }
            kmax_flush((LAS unsigned*)(lds + KMAXL_OFF), (unsigned*)(ws + WS_CTL) + CW_KMAX + l * 64, tid);
        }
        xcd_barrier(bar);

        if (PHASE_MASK & (1 << 3))
        {
            unsigned char* ws = P_WS();
            pg8::Gemm g{(const bf16_t*)(ws + WS_CQ), (const bf16_t*)(ws + ((l & 1) ? WALT : 0) + WS_WUQ), 512}; pg8::StaticOrder S; S.init(MT / 256, 3, G, (int)blockIdx.x, 8);
            pg8::EpiQ E{(bf16_t*)(ws + WS_QA), (const f32x2*)(ws + WS_ROPE)};
            pg8::gemm_phase<pg8::EpiQ, pg8::StaticOrder, 0>(lds, g, S, E);
        }
        if (PHASE_MASK & (1 << 4))
        {
            unsigned char* ws = P_WS();
            pg8::Gemm g{(const bf16_t*)(ws + WS_CKV), (const bf16_t*)(ws + ((l & 1) ? WALT : 0) + WS_WKV), 512}; pg8::StaticOrder S; S.init(MC / 256, 4, G, (int)blockIdx.x, 8);
            pg8::EpiKV E{(bf16_t*)(ws + WS_KA), (bf16_t*)(ws + WS_VA)};
            pg8::gemm_phase<pg8::EpiKV, pg8::StaticOrder, 0>(lds, g, S, E);
        }
        xcd_barrier(bar);

        if (PHASE_MASK & (1 << 5))
        for (int rep = 0; rep < 1 + DUP_BC; ++rep)
        {   unsigned char* ws = P_WS();
            att::Tens T{(const bf16_t*)(ws + WS_QC), 512, (const bf16_t*)(ws + WS_KC), nullptr, (const bf16_t*)(ws + WS_VC), (bf16_t*)(ws + WS_HEADS), nullptr, nullptr};
            att::attn_queue<2>(lds, T, (unsigned*)(ws + WS_CTL) + CW_Q + ((rep ? 12 + l : l * 3 + 0) * 8) * 64, (int)bar.x, P_IN(17) + (size_t)l * NMIX, P_IN(16) + (size_t)l * 4 * 257, (const unsigned*)(ws + WS_CTL) + CW_KMAX + l * 64); }
        if (PHASE_MASK & (1 << 6))
        for (int rep = 0; rep < 1 + DUP_A; ++rep)
        {   unsigned char* ws = P_WS();
            att::Tens T{(const bf16_t*)(ws + WS_QA), 768, (const bf16_t*)(ws + WS_KA), (const bf16_t*)(ws + WS_KR), (const bf16_t*)(ws + WS_VA), (bf16_t*)(ws + WS_HEADS), nullptr, nullptr};
            att::attn_queue<0>(lds, T, (unsigned*)(ws + WS_CTL) + CW_Q + ((rep ? 16 + l : l * 3 + 1) * 8) * 64, (int)bar.x, P_IN(17) + (size_t)l * NMIX, P_IN(16) + (size_t)l * 4 * 257, nullptr); }
        if (PHASE_MASK & (1 << 7))
        for (int rep = 0; rep < 1 + DUP_BC; ++rep)
        {   unsigned char* ws = P_WS();
            att::Tens T{(const bf16_t*)(ws + WS_QB), 512, (const bf16_t*)(ws + WS_KB), nullptr, (const bf16_t*)(ws + WS_VB), (bf16_t*)(ws + WS_HEADS), nullptr, nullptr};
            att::attn_queue<1>(lds, T, (unsigned*)(ws + WS_CTL) + CW_Q + ((rep ? 20 + l : l * 3 + 2) * 8) * 64, (int)bar.x, P_IN(17) + (size_t)l * NMIX, P_IN(16) + (size_t)l * 4 * 257, nullptr); }
        xcd_barrier(bar);

        if (PHASE_MASK & (1 << 8))
        {
            unsigned char* ws = P_WS();
            pg8::Gemm g{(const bf16_t*)(ws + WS_HEADS), (const bf16_t*)(ws + ((l & 1) ? WALT : 0) + WS_WOUT), NMIX}; pg8::TailOrder S; S.init(MP / 256, MS / 256, DM / 256, G, (int)blockIdx.x, NMIX / 64, NS_OUT, WGM_RES);
            pg8::EpiRes E{(bf16_t*)(ws + WS_H), (float*)(ws + WS_PART), NMIX / 64, (float*)(ws + WS_SSP)};
            pg8::gemm_phase<pg8::EpiRes, pg8::TailOrder, 0>(lds, g, S, E);
        }
        xcd_barrier(bar);

        if (PHASE_MASK & (1 << 9))
        for (int rep = 0; rep < 1 + DUP_N2; ++rep)
        {
            const int tid = fresh_tid(), lane = tid & 63, wave = __builtin_amdgcn_readfirstlane(tid >> 6), gw = blockIdx.x * 8 + wave;
            unsigned char* ws = P_WS(); bf16_t* XB = (bf16_t*)(ws + WS_H); const float* part = (const float*)(ws + WS_PART);
            float* ssq = (float*)(ws + WS_SSQ) + (size_t)(l * 2 + 1) * MT;
            for (int m = MP + gw; m < MT; m += NGW) prep_row_bf(XB + (size_t)m * DM, ssq + m, lane, part + (size_t)(m - MP) * DM, NS_OUT, (size_t)MS * DM);
            ssq_reduce((const float*)(ws + WS_SSP), ssq, blockIdx.x * 512 + tid, G * 512);
        }
        xcd_barrier(bar);

        if (PHASE_MASK & (1 << 10))
        for (int rep = 0; rep < 1 + DUP_UP; ++rep)
        {
            unsigned char* ws = P_WS(); float* out = P_OUT();
            pg8::Gemm g{(const bf16_t*)(ws + WS_H) - 2 * DM, (const bf16_t*)(ws + ((l & 1) ? WALT : 0) + WS_WUP), DM}; pg8::StaticOrder S; S.init(132, NUP / 256, G, (int)blockIdx.x, DM / 64);
            pg8::EpiUp E{(bf16_t*)(ws + WS_ACT), P_IN(21) + (size_t)l * 3 * NUP, P_IN(22) + (size_t)l * NUP, (float*)(ws + WS_SIDE), out + O_PCONV + (size_t)l * NB * 2 * NUP, out + O_SCONV + (size_t)l * SB * 2 * NUP, (const float*)(ws + WS_SSQ) + (size_t)(l * 2 + 1) * MT, lds + XCH_OFF};
            pg8::gemm_phase<pg8::EpiUp, pg8::StaticOrder, 2>(lds, g, S, E);
            if (rep == 0 && l + 1 < DEPTH && idle_up && (int)blockIdx.x >= idle_up) { __syncthreads(); w_items(l + 1, ((int)blockIdx.x - idle_up) * 8 + __builtin_amdgcn_readfirstlane((int)(fresh_tid() >> 6)), n_up, F1, F2); }
        }
        xcd_barrier(bar);

        if (PHASE_MASK & (1 << 12))
        {
            const int tid = fresh_tid();
            unsigned char* ws = P_WS(); const float* w_conv = P_IN(21); const float* b_conv = P_IN(22); const float* state_conv = P_IN(8); bf16_t* ACT = (bf16_t*)(ws + WS_ACT);
            for (int e = blockIdx.x * 512 + tid; e < 20 * DFF; e += G * 512) {
                const int rs = e / DFF, j = e - rs * DFF, sq = rs >> 1, ts = rs & 1;
                const float* sd = (const float*)(ws + WS_SIDE) + (size_t)sq * 2 * NUP; const float* wc3 = w_conv + (size_t)l * 3 * NUP; const float* bc = b_conv + (size_t)l * NUP;
                float cv[2];
#pragma unroll
                for (int part = 0; part < 2; ++part) { const int col = part * DFF + j;
                    float s0 = 0.f, s1 = 0.f; if (sq >= 2) { const float* st = state_conv + ((size_t)l * SB + (sq - 2)) * 2 * NUP; s0 = st[col]; s1 = st[NUP + col]; }
                    const float ut = sd[ts * NUP + col], u1 = ts ? sd[col] : s1, u2 = ts ? s1 : s0;
                    cv[part] = bc[col] + wc3[col] * u2 + wc3[NUP + col] * u1 + wc3[2 * NUP + col] * ut; }
                const int row = (sq < 2 ? sq * SEQ : MP + (sq - 2) * SS) + ts;
                const float r = cv[0] * __builtin_amdgcn_rcpf(1.f + __expf(-cv[0])) * cv[1];
                ACT[(size_t)row * DFF + j] = (bf16_t)(cvtpk(r, 0.f) & 0xffffu);
            }
        }
        xcd_barrier(bar);

        if (PHASE_MASK & (1 << 11))
        {
            unsigned char* ws = P_WS();
            pg8::Gemm g{(const bf16_t*)(ws + WS_ACT), (const bf16_t*)(ws + ((l & 1) ? WALT : 0) + WS_WDN), DFF}; pg8::TailOrder S; S.init(MP / 256, MS / 256, DM / 256, G, (int)blockIdx.x, DFF / 64, NS_DOWN, WGM_RES);
            pg8::EpiRes E{(bf16_t*)(ws + WS_H), (float*)(ws + WS_PART), DFF / 64, (float*)(ws + WS_SSP)};
            pg8::gemm_phase<pg8::EpiRes, pg8::TailOrder, 0>(lds, g, S, E);
        }
        xcd_barrier(bar);
    }
    {
        const int tid = fresh_tid(), lane = tid & 63, wave = __builtin_amdgcn_readfirstlane(tid >> 6), gw = blockIdx.x * 8 + wave;
        float* Y = P_OUT(); const float* gfin = P_IN(24);
        unsigned char* ws = P_WS(); const bf16_t* XB = (const bf16_t*)(ws + WS_H); const float* part = (const float*)(ws + WS_PART); const float* ssp = (const float*)(ws + WS_SSP);
        for (int m = gw; m < MT; m += NGW) { if (m < MP) final_row(XB + (size_t)m * DM, Y + (size_t)m * DM, gfin, lane, ssp + (size_t)m * 32); else final_row(XB + (size_t)m * DM, Y + (size_t)m * DM, gfin, lane, nullptr, part + (size_t)(m - MP) * DM, NS_DOWN, (size_t)MS * DM); }
    }
}

extern "C" void kernel_launch(void* const* d_in, const int* in_sizes, int n_in, void* d_out, int out_size, void* d_ws, size_t ws_size, hipStream_t stream) {
    static int grid = 0;
    if (grid == 0) {
        if (n_in != 25 || (size_t)out_size != O_END || ws_size < WS_END) { fprintf(stderr, "kernel_launch: unexpected sizes (n_in %d, out %d, ws %zu; need out %zu, ws >= %zu); nothing launched\n", n_in, out_size, ws_size, (size_t)O_END, (size_t)WS_END); grid = -1; return; }
        int dev = 0, cus = 0, per_cu = 0;
        if (hipGetDevice(&dev) != hipSuccess || hipDeviceGetAttribute(&cus, hipDeviceAttributeMultiprocessorCount, dev) != hipSuccess) { grid = -1; return; }
        if (hipFuncSetAttribute((const void*)fwd_kernel, hipFuncAttributeMaxDynamicSharedMemorySize, LDS_BYTES) != hipSuccess) { fprintf(stderr, "kernel_launch: hipFuncSetAttribute failed\n"); grid = -1; return; }
        if (hipOccupancyMaxActiveBlocksPerMultiprocessor(&per_cu, (const void*)fwd_kernel, 512, LDS_BYTES) != hipSuccess || per_cu < 1) fprintf(stderr, "kernel_launch: occupancy query reports %d\n", per_cu);
        (void)hipGetLastError();
        grid = cus;
    }
    if (grid < 0) return;
    if (hipMemsetAsync((char*)d_ws + WS_CTL, 0, CTL_ZERO_BYTES, stream) != hipSuccess) return;
    Args a{};
    for (int i = 0; i < 25; ++i) a.in[i] = (const float*)d_in[i];
    a.out = (float*)d_out; a.ws = (unsigned char*)d_ws;
    hipLaunchKernelGGL(fwd_kernel, dim3(grid), dim3(512), LDS_BYTES, stream, a);
}
```

```cpp
#include <hip/hip_runtime.h>
#include <cstdio>
#include <cstdint>

#define LAS __attribute__((address_space(3)))
#define GAS __attribute__((address_space(1)))
typedef unsigned short bf16_t;
typedef short bf16x8 __attribute__((ext_vector_type(8)));
typedef short s16x4 __attribute__((ext_vector_type(4)));
typedef float f32x2 __attribute__((ext_vector_type(2)));
typedef float f32x4 __attribute__((ext_vector_type(4)));
typedef float f32x16 __attribute__((ext_vector_type(16)));
typedef unsigned u32x2 __attribute__((ext_vector_type(2)));
typedef unsigned u32x4 __attribute__((ext_vector_type(4)));
typedef __bf16 bf16x2_t __attribute__((ext_vector_type(2)));

constexpr int DM = 2048, NB = 2, SEQ = 16384, DEPTH = 4, SB = 8, SS = 64, PAST = 1024;
constexpr int MP = NB * SEQ, MS = SB * SS, MT = MP + MS;
constexpr int CSTR = PAST + SS, BSTR = 512 + SS;
constexpr int MC = MP + SB * CSTR, MBB = MP + SB * BSTR;
constexpr int NIN = 4352, DFF = 5632, NUP = 2 * DFF, NMIX = 1536;
constexpr float EPS = 1e-6f;
constexpr float LOG2E = 1.4426950408889634f;
constexpr float SC_A = 0.07216878364870322f * LOG2E;
constexpr float SC_BC = 0.08838834764831845f * LOG2E;

constexpr size_t O_YP = 0, O_YS = O_YP + (size_t)MP * DM, O_PACKV = O_YS + (size_t)MS * DM, O_PAKR = O_PACKV + (size_t)DEPTH * MP * 512,
    O_PBK = O_PAKR + (size_t)DEPTH * MP * 64, O_PBV = O_PBK + (size_t)DEPTH * NB * 512 * 512, O_PCK = O_PBV + (size_t)DEPTH * NB * 512 * 512,
    O_PCV = O_PCK + (size_t)DEPTH * MP * 512, O_PCONV = O_PCV + (size_t)DEPTH * MP * 512, O_SACKV = O_PCONV + (size_t)DEPTH * NB * 2 * NUP,
    O_SAKR = O_SACKV + (size_t)DEPTH * MS * 512, O_SBK = O_SAKR + (size_t)DEPTH * MS * 64, O_SBV = O_SBK + (size_t)DEPTH * MS * 512,
    O_SCK = O_SBV + (size_t)DEPTH * MS * 512, O_SCV = O_SCK + (size_t)DEPTH * MS * 512, O_SCONV = O_SCV + (size_t)DEPTH * MS * 512,
    O_END = O_SCONV + (size_t)DEPTH * SB * 2 * NUP;

constexpr size_t AL(size_t x) { return (x + 4095) & ~(size_t)4095; }
constexpr size_t WS_CTL = 0, CTL_ZERO_BYTES = 1u << 20;
constexpr size_t WS_ROPE = CTL_ZERO_BYTES;
constexpr size_t WS_SIDE = WS_ROPE + (size_t)SEQ * 32 * 8;
constexpr size_t WS_WIN = AL(WS_SIDE + (size_t)10 * 2 * NUP * 4);
constexpr size_t WS_WUQ = WS_WIN + (size_t)NIN * DM * 2;
constexpr size_t WS_WKV = WS_WUQ + (size_t)768 * 512 * 2;
constexpr size_t WS_WOUT = WS_WKV + (size_t)1024 * 512 * 2;
constexpr size_t WS_WUP = WS_WOUT + (size_t)DM * NMIX * 2;
constexpr size_t WS_WDN = WS_WUP + (size_t)NUP * DM * 2;
constexpr size_t WS_HG = WS_WDN + (size_t)DM * DFF * 2;
constexpr size_t WS_H = WS_HG + 16384;
constexpr size_t WS_ATT = AL(WS_H + (size_t)(MT + 512) * DM * 2);
constexpr size_t WS_CQ = WS_ATT;
constexpr size_t WS_QA = WS_CQ + (size_t)MT * 512 * 2;
constexpr size_t WS_CKV = WS_QA + (size_t)MT * 768 * 2;
constexpr size_t WS_KR = WS_CKV + (size_t)MC * 512 * 2;
constexpr size_t WS_KA = WS_KR + (size_t)MC * 64 * 2;
constexpr size_t WS_VA = WS_KA + (size_t)MC * 512 * 2;
constexpr size_t WS_QB = WS_VA + (size_t)MC * 512 * 2;
constexpr size_t WS_KB = WS_QB + (size_t)MT * 512 * 2;
constexpr size_t WS_VB = WS_KB + (size_t)MBB * 512 * 2;
constexpr size_t WS_QC = WS_VB + (size_t)MBB * 512 * 2;
constexpr size_t WS_KC = WS_QC + (size_t)MT * 512 * 2;
constexpr size_t WS_VC = WS_KC + (size_t)MC * 512 * 2;
constexpr size_t WS_HEADS = WS_VC + (size_t)MC * 512 * 2;
constexpr size_t WS_ATT_END = WS_HEADS + (size_t)MT * NMIX * 2;
constexpr size_t WS_ACT = WS_ATT;
constexpr size_t WS_PART = AL((WS_ATT_END > WS_ACT + (size_t)MT * DFF * 2 ? WS_ATT_END : WS_ACT + (size_t)MT * DFF * 2) + 65536);
constexpr int NS_DOWN = 11, NS_OUT = 6;
constexpr size_t WS_SSQ = AL(WS_PART + (size_t)NS_DOWN * MS * DM * 4);
constexpr size_t SSQ_BYTES = (size_t)(DEPTH + 1) * 2 * MT * 4;
constexpr size_t WS_SSP = AL(WS_SSQ + SSQ_BYTES);
constexpr size_t WS_W2 = AL(WS_SSP + (size_t)MT * 32 * 4) + 65536;
constexpr size_t WALT = WS_W2 - WS_WIN;
constexpr size_t WS_END = AL(WS_W2 + (WS_HG - WS_WIN)) + 65536;
static_assert(WS_END < (size_t)1000 * 1000 * 1000, "workspace map");

constexpr int CW_BAR = 4096;
constexpr int CW_Q = 16384;
constexpr int CW_KMAX = 65536;
constexpr int KMAXL_OFF = 131072 + 2048;
constexpr int XCH_OFF = 131072 + 4096;

constexpr int RING_BYTES = 131072, MISC_OFF = RING_BYTES + 320, LDS_BYTES = 147456;

__device__ __forceinline__ unsigned cvtpk(float lo, float hi) { f32x2 v = {lo, hi}; bf16x2_t b = __builtin_convertvector(v, bf16x2_t); return __builtin_bit_cast(unsigned, b); }
__device__ __forceinline__ float bf_lo(unsigned u) { return __uint_as_float(u << 16); }
__device__ __forceinline__ float bf_hi(unsigned u) { return __uint_as_float(u & 0xffff0000u); }
__device__ __forceinline__ float wave_sum(float v) {
#pragma unroll
    for (int o = 1; o < 64; o <<= 1) v += __shfl_xor(v, o);
    return v;
}
#define LDS_WAIT() asm volatile("s_waitcnt lgkmcnt(0)" ::: "memory")
#define VM_WAIT() asm volatile("s_waitcnt vmcnt(0)" ::: "memory")
__device__ __forceinline__ int fresh_tid() { int t = threadIdx.x; asm volatile("" : "+v"(t)); return t; }
namespace pg8 {
constexpr int BM = 256, BK = 64, HALF = 128, HTB = HALF * BK * 2, STAGE_BYTES = 8 * HTB, NXCD = 8, WGM = 4;
__host__ __device__ __forceinline__ int lds_byte(int r, int c) { const int st = (r >> 4) * 2 + (c >> 5), rr = r & 15, cc = c & 31, ob = rr * 64 + cc * 2; return st * 1024 + (ob ^ (((ob >> 9) & 1) << 5)); }
__host__ __device__ __forceinline__ void stage_rc(int b, int& R, int& C) { const int st = b / 1024, sb = b % 1024, swz = sb ^ (((sb >> 9) & 1) << 5); R = (st >> 1) * 16 + swz / 64; C = (st & 1) * 32 + (swz % 64) / 2; }
__host__ __device__ __forceinline__ int perm32(int rho) { const int n = rho >> 4, i = rho & 15; return 8 * (i >> 2) + 4 * n + (i & 3); }

struct Unit { int pm, pn, k0, nk; };
struct Gemm { const bf16_t* A; const bf16_t* Bt; int K; };

struct StaticOrder {
    int nM, nN, nwg, G, c, nkt, wgm;
    __device__ void init(int nM_, int nN_, int G_, int c_, int nkt_, int wgm_ = WGM) { nM = nM_; nN = nN_; nwg = nM * nN; G = G_; c = c_; nkt = nkt_; wgm = wgm_; }
    __device__ void map(int wgid, Unit& u) const {
        { const int q = nwg / NXCD, r = nwg % NXCD, xcd = wgid % NXCD, off = wgid / NXCD; wgid = (xcd < r ? xcd * (q + 1) : r * (q + 1) + (xcd - r) * q) + off; }
        const int nig = wgm * nN, gid = wgid / nig, fm = gid * wgm, gsz = (nM - fm) < wgm ? (nM - fm) : wgm;
        u.pm = fm + ((wgid % nig) % gsz); u.pn = (wgid % nig) / gsz; u.k0 = 0; u.nk = nkt;
    }
    __device__ bool next(int i, Unit& u) const { const long L = (long)i * G + c; if (L >= nwg) return false; map((int)L, u); return true; }
};
struct TailOrder {
    StaticOrder so; int nMt, NS, nks;
    __device__ void init(int nMf, int nMt_, int nN, int G, int c, int nkt, int NS_, int wgm_ = WGM) { so.init(nMf, nN, G, c, nkt, wgm_); nMt = nMt_; NS = NS_; nks = nkt / NS_; }
    __device__ bool next(int i, Unit& u) const {
        const long L = (long)i * so.G + so.c;
        if (L < so.nwg) { so.map((int)L, u); return true; }
        const int r = (int)(L - so.nwg); if (r >= nMt * so.nN * NS) return false;
        const int s = r % NS, t = r / NS; u.pn = t % so.nN; u.pm = so.nM + t / so.nN; u.k0 = s * nks; u.nk = nks; return true;
    }
};

template <class Epi, class Sched, int AMODE>
__device__ __forceinline__ void gemm_phase(LAS unsigned char* lds, const Gemm g, const Sched& S, const Epi& E) {
    const int tid = fresh_tid(), wid = __builtin_amdgcn_readfirstlane(tid >> 6), lane = tid & 63, wr = wid >> 2, wc = wid & 3, fr = lane & 15, fq = lane >> 4;
    const int K = g.K;
    unsigned voffA[2], voffB[2];
#pragma unroll
    for (int i = 0; i < 2; ++i) { int R, C; stage_rc(tid * 16 + i * 8192, R, C); const int Rb = Epi::PERM ? ((R & ~31) + perm32(R & 31)) : R; const int Ra = (AMODE == 1) ? (62 * (R >> 6) + (R & 63)) : R;
        voffA[i] = (unsigned)(Ra * K + C) * 2u; voffB[i] = (unsigned)(Rb * K + C) * 2u; }
    const size_t kstep = (size_t)(BK * 2);
    const size_t hstepB = (size_t)HALF * K * 2, tstepB = 2 * hstepB;
    const size_t hstepA = (size_t)(AMODE == 1 ? 124 : 128) * K * 2, tstepA = (AMODE == 2) ? (size_t)254 * K * 2 : 2 * hstepA;
    const unsigned ldsw = (unsigned)wid * 1024u;
    const int aoff = lds_byte(wr * 64 + fr, fq * 8), boff = lds_byte(wc * 32 + fr, fq * 8);
#define PG8_SA(b, h) (((b) * 2 + (h)) * HTB)
#define PG8_SB(b, h) ((4 + (b) * 2 + (h)) * HTB)
#define PG8_STAGE(bufoff, gbase, voff) do { _Pragma("unroll") for (int _i = 0; _i < 2; ++_i) \
        __builtin_amdgcn_global_load_lds((const unsigned*)((const char*)(gbase) + (voff)[_i]), (LAS unsigned*)(lds + (bufoff) + ldsw + _i * 8192), 16, 0, 0); } while (0)
#define PG8_LDA(dst, b, h) do { _Pragma("unroll") for (int m = 0; m < 4; ++m) _Pragma("unroll") for (int k = 0; k < 2; ++k) dst[m][k] = *(const LAS bf16x8*)(lds + PG8_SA(b, h) + aoff + m * 2048 + k * 1024); } while (0)
#define PG8_LDB(dst, b, h) do { _Pragma("unroll") for (int n = 0; n < 2; ++n) _Pragma("unroll") for (int k = 0; k < 2; ++k) dst[n][k] = *(const LAS bf16x8*)(lds + PG8_SB(b, h) + boff + n * 2048 + k * 1024); } while (0)
#define PG8_MMA(ai, bj, At, Bt) do { __builtin_amdgcn_s_setprio(1); _Pragma("unroll") for (int m = 0; m < 4; ++m) _Pragma("unroll") for (int n = 0; n < 2; ++n) _Pragma("unroll") for (int k = 0; k < 2; ++k) \
        acc[ai][bj][m][n] = __builtin_amdgcn_mfma_f32_16x16x32_bf16(Bt[n][k], At[m][k], acc[ai][bj][m][n], 0, 0, 0); __builtin_amdgcn_s_setprio(0); } while (0)
#define PG8_WAIT_V(n) asm volatile("s_waitcnt vmcnt(" #n ")" ::: "memory")
#define PG8_WAIT_L(n) asm volatile("s_waitcnt lgkmcnt(" #n ")" ::: "memory")
#define PG8_BAR __builtin_amdgcn_s_barrier()
#define PG8_SCHED __builtin_amdgcn_sched_barrier(0)
    Unit cur, nxt; int ui = 0;
    if (!S.next(0, cur)) return;
    f32x4 acc[2][2][4][2];
#pragma unroll
    for (int a = 0; a < 2; ++a)
#pragma unroll
        for (int b = 0; b < 2; ++b)
#pragma unroll
            for (int m = 0; m < 4; ++m)
#pragma unroll
                for (int n = 0; n < 2; ++n) acc[a][b][m][n] = (f32x4){0.f, 0.f, 0.f, 0.f};
    bf16x8 At[4][2], B0[2][2], B1[2][2];
    const char* cA = (const char*)g.A + (size_t)cur.pm * tstepA + (size_t)cur.k0 * kstep; const char* cB = (const char*)g.Bt + (size_t)cur.pn * tstepB + (size_t)cur.k0 * kstep;
    PG8_STAGE(PG8_SB(0, 0), cB, voffB); PG8_STAGE(PG8_SB(0, 1), cB + hstepB, voffB); PG8_STAGE(PG8_SA(0, 0), cA, voffA); PG8_STAGE(PG8_SA(0, 1), cA + hstepA, voffA);
    if (wr == 1) PG8_BAR;
    PG8_WAIT_V(2); PG8_BAR;
    PG8_STAGE(PG8_SB(1, 0), cB + kstep, voffB); PG8_STAGE(PG8_SA(1, 0), cA + kstep, voffA); PG8_STAGE(PG8_SB(1, 1), cB + hstepB + kstep, voffB);
    PG8_WAIT_V(6); PG8_BAR;
    for (;;) {
        const bool has_next = S.next(ui + 1, nxt);
        const char* nA = has_next ? (const char*)g.A + (size_t)nxt.pm * tstepA + (size_t)nxt.k0 * kstep : cA; const char* nB = has_next ? (const char*)g.Bt + (size_t)nxt.pn * tstepB + (size_t)nxt.k0 * kstep : cB;
        const int nt = cur.nk;
        for (int t = 0; t < nt; t += 2) {
            const bool last = (t == nt - 2);
            const char* a1 = cA + (size_t)(t + 1) * kstep;
            const char* a2 = last ? nA : cA + (size_t)(t + 2) * kstep; const char* b2 = last ? nB : cB + (size_t)(t + 2) * kstep;
            const char* a3 = a2 + kstep; const char* b3 = b2 + kstep;
            PG8_LDB(B0, 0, 0); PG8_LDB(B1, 0, 1); PG8_SCHED; PG8_LDA(At, 0, 0); PG8_STAGE(PG8_SA(1, 1), a1 + hstepA, voffA);
            PG8_WAIT_V(8); PG8_WAIT_L(0); PG8_BAR; PG8_MMA(0, 0, At, B0); PG8_MMA(0, 1, At, B1); PG8_BAR; PG8_SCHED;
            PG8_LDA(At, 0, 1); PG8_STAGE(PG8_SB(0, 0), b2, voffB); PG8_STAGE(PG8_SB(0, 1), b2 + hstepB, voffB); PG8_STAGE(PG8_SA(0, 0), a2, voffA);
            PG8_WAIT_V(8); PG8_WAIT_L(0); PG8_BAR; PG8_MMA(1, 0, At, B0); PG8_MMA(1, 1, At, B1); PG8_BAR; PG8_SCHED;
            PG8_LDB(B0, 1, 0); PG8_LDB(B1, 1, 1); PG8_SCHED; PG8_LDA(At, 1, 0); PG8_STAGE(PG8_SA(0, 1), a2 + hstepA, voffA);
            PG8_WAIT_V(8); PG8_WAIT_L(0); PG8_BAR; PG8_MMA(0, 0, At, B0); PG8_MMA(0, 1, At, B1); PG8_BAR; PG8_SCHED;
            PG8_LDA(At, 1, 1); PG8_STAGE(PG8_SB(1, 0), b3, voffB); PG8_STAGE(PG8_SB(1, 1), b3 + hstepB, voffB); PG8_STAGE(PG8_SA(1, 0), a3, voffA);
            PG8_WAIT_V(8); PG8_WAIT_L(0); PG8_BAR; PG8_MMA(1, 0, At, B0); PG8_MMA(1, 1, At, B1); PG8_BAR; PG8_SCHED;
        }
        if (wr == 0) PG8_BAR;
        E(acc, cur, wr, wc, fr, fq);
        if (!has_next) break;
#pragma unroll
        for (int a = 0; a < 2; ++a)
#pragma unroll
            for (int b = 0; b < 2; ++b)
#pragma unroll
                for (int m = 0; m < 4; ++m)
#pragma unroll
                    for (int n = 0; n < 2; ++n) acc[a][b][m][n] = (f32x4){0.f, 0.f, 0.f, 0.f};
        cur = nxt; cA = nA; cB = nB; ++ui;
        if (wr == 1) PG8_BAR;
    }
    PG8_WAIT_V(0);
    PG8_BAR;
#undef PG8_SA
#undef PG8_SB
#undef PG8_STAGE
#undef PG8_LDA
#undef PG8_LDB
#undef PG8_MMA
#undef PG8_WAIT_V
#undef PG8_WAIT_L
#undef PG8_BAR
#undef PG8_SCHED
}
}
namespace pg8 {
template <int CTRL> __device__ __forceinline__ float dpp_f(float x) { return __builtin_bit_cast(float, __builtin_amdgcn_update_dpp(0, __builtin_bit_cast(int, x), CTRL, 0xf, 0xf, true)); }
__device__ __forceinline__ int map_c(int m) { if (m < MP) return m; const int ms = m - MP; return MP + (ms >> 6) * CSTR + PAST + (ms & 63); }
__device__ __forceinline__ int map_b(int m) { if (m < MP) return m; const int ms = m - MP; return MP + (ms >> 6) * BSTR + 512 + (ms & 63); }

struct EpiIn {
    static constexpr bool PERM = true;
    unsigned char* ws; float* out; int l; const float* ssq;
    __device__ __forceinline__ void operator()(const f32x4 (&acc)[2][2][4][2], const Unit& u, int wr, int wc, int fr, int fq) const {
        const int pn = u.pn; const bool smp = u.pm >= (MP / 256);
        size_t doff = WS_CQ, fbase = 0; int pitch = 512, sub = pn & 1, rowmode = 0, fkind = 0; float sc = 1.f;
        if (pn < 2) { doff = WS_CQ; }
        else if (pn < 4) { doff = WS_CKV; rowmode = 1; }
        else if (pn < 10) { const int w = (pn - 4) >> 1; if (w == 0) { doff = WS_QB; sc = SC_BC; } else { doff = (w == 1) ? WS_KB : WS_VB; rowmode = 2; fkind = 1;
                fbase = smp ? (w == 1 ? O_SBK : O_SBV) + (size_t)l * MS * 512 : (w == 1 ? O_PBK : O_PBV) + (size_t)l * NB * 512 * 512; } }
        else if (pn < 16) { const int w = (pn - 10) >> 1; if (w == 0) { doff = WS_QC; sc = SC_BC; } else { doff = (w == 1) ? WS_KC : WS_VC; rowmode = 1; fkind = 2;
                fbase = smp ? (w == 1 ? O_SCK : O_SCV) + (size_t)l * MS * 512 : (w == 1 ? O_PCK : O_PCV) + (size_t)l * MP * 512; } }
        else { doff = WS_KR; pitch = 64; sub = 0; rowmode = 1; }
        bf16_t* dst = (bf16_t*)(ws + doff); float* fo = out + fbase;
        const int lc0 = 256 * sub + 32 * wc + 8 * fq;
#pragma unroll
        for (int ai = 0; ai < 2; ++ai)
#pragma unroll
            for (int m = 0; m < 4; ++m) {
                const int mrow = u.pm * 256 + ai * 128 + wr * 64 + m * 16 + fr;
                const int drow = rowmode == 0 ? mrow : (rowmode == 1 ? map_c(mrow) : map_b(mrow));
                const float rs = 1.0f / sqrtf(ssq[mrow] * (1.f / DM) + EPS), scr = sc * rs;
                long foff = -1;
                if (fkind) {
                    if (smp) foff = (long)(mrow - MP) * 512;
                    else if (fkind == 2) foff = (long)mrow * 512;
                    else { const int t = mrow & (SEQ - 1), b = mrow >> 14; if (t >= SEQ - 512) foff = (long)(b * 512 + (t - (SEQ - 512))) * 512; }
                }
#pragma unroll
                for (int bj = 0; bj < 2; ++bj) {
                    const int lc = lc0 + bj * 128;
                    if (pn == 16 && lc >= 64) continue;
                    const f32x4 v0 = acc[ai][bj][m][0], v1 = acc[ai][bj][m][1];
                    u32x4 w; w.x = cvtpk(v0[0] * scr, v0[1] * scr); w.y = cvtpk(v0[2] * scr, v0[3] * scr); w.z = cvtpk(v1[0] * scr, v1[1] * scr); w.w = cvtpk(v1[2] * scr, v1[3] * scr);
                    *(u32x4*)(dst + (size_t)drow * pitch + lc) = w;
                    if (foff >= 0) { float* fp = fo + foff + lc; __builtin_nontemporal_store(v0 * rs, (f32x4*)fp); __builtin_nontemporal_store(v1 * rs, (f32x4*)(fp + 4)); }
                }
            }
    }
};

struct EpiQ {
    static constexpr bool PERM = true;
    bf16_t* QA; const f32x2* rope;
    __device__ __forceinline__ void operator()(const f32x4 (&acc)[2][2][4][2], const Unit& u, int wr, int wc, int fr, int fq) const {
#pragma unroll
        for (int bj = 0; bj < 2; ++bj) {
            const int c0 = 256 * u.pn + 128 * bj + 32 * wc + 8 * fq, j = c0 % 192; const bool isrope = j >= 128; const int i0 = (j - 128) >> 1;
#pragma unroll
            for (int ai = 0; ai < 2; ++ai)
#pragma unroll
                for (int m = 0; m < 4; ++m) {
                    const int mrow = u.pm * 256 + ai * 128 + wr * 64 + m * 16 + fr;
                    f32x4 v0 = acc[ai][bj][m][0], v1 = acc[ai][bj][m][1];
                    if (isrope) {
                        const int pos = mrow < MP ? (mrow & (SEQ - 1)) : PAST + ((mrow - MP) & 63);
                        const f32x4* cs = (const f32x4*)(rope + (size_t)pos * 32 + i0);
                        const f32x4 ca = cs[0], cb = cs[1];
                        f32x4 r0, r1;
                        r0[0] = v0[0] * ca[0] - v0[1] * ca[1]; r0[1] = v0[0] * ca[1] + v0[1] * ca[0];
                        r0[2] = v0[2] * ca[2] - v0[3] * ca[3]; r0[3] = v0[2] * ca[3] + v0[3] * ca[2];
                        r1[0] = v1[0] * cb[0] - v1[1] * cb[1]; r1[1] = v1[0] * cb[1] + v1[1] * cb[0];
                        r1[2] = v1[2] * cb[2] - v1[3] * cb[3]; r1[3] = v1[2] * cb[3] + v1[3] * cb[2];
                        v0 = r0; v1 = r1;
                    }
                    u32x4 w; w.x = cvtpk(v0[0] * SC_A, v0[1] * SC_A); w.y = cvtpk(v0[2] * SC_A, v0[3] * SC_A); w.z = cvtpk(v1[0] * SC_A, v1[1] * SC_A); w.w = cvtpk(v1[2] * SC_A, v1[3] * SC_A);
                    *(u32x4*)(QA + (size_t)mrow * 768 + c0) = w;
                }
        }
    }
};

struct EpiKV {
    static constexpr bool PERM = true;
    bf16_t *KA, *VA;
    __device__ __forceinline__ void operator()(const f32x4 (&acc)[2][2][4][2], const Unit& u, int wr, int wc, int fr, int fq) const {
        bf16_t* dst = (u.pn < 2) ? KA : VA; const int lc0 = 256 * (u.pn & 1) + 32 * wc + 8 * fq;
#pragma unroll
        for (int ai = 0; ai < 2; ++ai)
#pragma unroll
            for (int m = 0; m < 4; ++m) {
                const int row = u.pm * 256 + ai * 128 + wr * 64 + m * 16 + fr;
#pragma unroll
                for (int bj = 0; bj < 2; ++bj) {
                    const f32x4 v0 = acc[ai][bj][m][0], v1 = acc[ai][bj][m][1];
                    u32x4 w; w.x = cvtpk(v0[0], v0[1]); w.y = cvtpk(v0[2], v0[3]); w.z = cvtpk(v1[0], v1[1]); w.w = cvtpk(v1[2], v1[3]);
                    *(u32x4*)(dst + (size_t)row * 512 + lc0 + bj * 128) = w;
                }
            }
    }
};

struct EpiRes {
    static constexpr bool PERM = true;
    bf16_t* XB; float* part; int nkt; float* ssp;
    __device__ __forceinline__ void operator()(const f32x4 (&acc)[2][2][4][2], const Unit& u, int wr, int wc, int fr, int fq) const {
        const int col0 = u.pn * 256 + wc * 32 + 8 * fq;
        const bool split = u.nk != nkt;
        const int slice = split ? u.k0 / u.nk : 0;
#pragma unroll
        for (int ai = 0; ai < 2; ++ai)
#pragma unroll
            for (int m = 0; m < 4; ++m) {
                const int row = u.pm * 256 + ai * 128 + wr * 64 + m * 16 + fr;
                if (split) {
                    float* op = part + ((size_t)slice * MS + (size_t)(row - MP)) * DM + col0;
#pragma unroll
                    for (int bj = 0; bj < 2; ++bj) { *(f32x4*)(op + bj * 128) = acc[ai][bj][m][0]; *(f32x4*)(op + bj * 128 + 4) = acc[ai][bj][m][1]; }
                } else {
                    bf16_t* xp = XB + (size_t)row * DM + col0;
                    float s = 0.f;
#pragma unroll
                    for (int bj = 0; bj < 2; ++bj) {
                        const u32x4 b = *(const u32x4*)(xp + bj * 128);
                        const f32x4 a0 = acc[ai][bj][m][0], a1 = acc[ai][bj][m][1];
                        const float x0 = bf_lo(b.x) + a0[0], x1 = bf_hi(b.x) + a0[1], x2 = bf_lo(b.y) + a0[2], x3 = bf_hi(b.y) + a0[3], x4 = bf_lo(b.z) + a1[0], x5 = bf_hi(b.z) + a1[1], x6 = bf_lo(b.w) + a1[2], x7 = bf_hi(b.w) + a1[3];
                        s += (x0 * x0 + x1 * x1) + (x2 * x2 + x3 * x3) + (x4 * x4 + x5 * x5) + (x6 * x6 + x7 * x7);
                        u32x4 w; w.x = cvtpk(x0, x1); w.y = cvtpk(x2, x3); w.z = cvtpk(x4, x5); w.w = cvtpk(x6, x7);
                        *(u32x4*)(xp + bj * 128) = w;
                    }
                    s += __shfl_xor(s, 16); s += __shfl_xor(s, 32);
                    if (fq == 0) ssp[(size_t)row * 32 + u.pn * 4 + wc] = s;
                }
            }
    }
};

struct EpiUp {
    static constexpr bool PERM = true;
    bf16_t* ACT; const float *wconv, *bconv; float *side, *pconv, *sconv; const float* ssq; LAS unsigned char* xch;
    __device__ __forceinline__ void operator()(f32x4 (&acc)[2][2][4][2], const Unit& u, int wr_, int wc_, int fr_, int fq_) const {
        const bool rare_tile = u.pm == 0 || u.pm == 64 || u.pm >= 129;
        {
            int wr = wr_, wc = wc_, fr = fr_, fq = fq_; asm volatile("" : "+v"(fr), "+v"(fq)); asm volatile("" : "+s"(wr), "+s"(wc));
#pragma unroll
            for (int ai = 0; ai < 2; ++ai)
#pragma unroll
                for (int m = 0; m < 4; ++m) { int grow = 254 * u.pm + 128 * ai + 64 * wr + 16 * m + fr - 2; grow = grow < 0 ? 0 : (grow > MT - 1 ? MT - 1 : grow);
                    const float rs = 1.0f / sqrtf(ssq[grow] * (1.f / DM) + EPS);
#pragma unroll
                    for (int bj = 0; bj < 2; ++bj)
#pragma unroll
                        for (int n = 0; n < 2; ++n) acc[ai][bj][m][n] *= rs; }
            if (fr >= 14) {
#pragma unroll
                for (int ai = 0; ai < 2; ++ai)
#pragma unroll
                    for (int bj = 0; bj < 2; ++bj)
#pragma unroll
                        for (int n = 0; n < 2; ++n) *(LAS f32x4*)(xch + ((((((wc * 4 + 2 * ai + wr) * 2 + bj) * 2 + n) * 4 + fq) * 2) + (fr - 14)) * 16) = acc[ai][bj][3][n];
            }
            asm volatile("s_waitcnt lgkmcnt(0)" ::: "memory"); __builtin_amdgcn_s_barrier(); asm volatile("" ::: "memory");
            __builtin_amdgcn_sched_barrier(0);
        }
#pragma unroll
        for (int bj = 0; bj < 2; ++bj)
#pragma unroll
            for (int n = 0; n < 2; ++n) {
                int wr = wr_, wc = wc_, fr = fr_, fq = fq_;
                asm volatile("" : "+v"(fr), "+v"(fq));
                asm volatile("" : "+s"(wr), "+s"(wc));
                const int col = bj * DFF + 128 * u.pn + 32 * wc + 8 * fq + 4 * n;
                const f32x4 w0 = *(const f32x4*)(wconv + col), w1 = *(const f32x4*)(wconv + NUP + col), w2 = *(const f32x4*)(wconv + 2 * NUP + col), bb = *(const f32x4*)(bconv + col);
#pragma unroll
                for (int ai = 0; ai < 2; ++ai) {
                    const int gabove = 2 * ai + wr - 1;
                    const f32x4 xq = *(const LAS f32x4*)(xch + ((((((wc * 4 + (gabove < 0 ? 0 : gabove)) * 2 + bj) * 2 + n) * 4 + fq) * 2) + (fr & 1)) * 16);
#pragma unroll
                    for (int mm = 0; mm < 4; ++mm) {
                        const int m = 3 - mm;
                        const int R = 128 * ai + 64 * wr + 16 * m + fr, grow = 254 * u.pm + R - 2;
                        asm volatile("" : "+v"(acc[ai][bj][m][n]), "+v"(acc[ai][bj][m > 0 ? m - 1 : 0][n]));
                        const f32x4 v = acc[ai][bj][m][n], q = (m > 0) ? acc[ai][bj][m > 0 ? m - 1 : 0][n] : xq;
                        f32x4 p1, p2;
#pragma unroll
                        for (int c = 0; c < 4; ++c) { p1[c] = dpp_f<0x121>((fr == 15) ? q[c] : v[c]); p2[c] = dpp_f<0x122>((fr >= 14) ? q[c] : v[c]); }
                        if (rare_tile) {
                        const bool ok = R >= 2 && grow < MT, smp = grow >= MP;
                        const int g2 = smp ? grow - MP : grow, tseq = smp ? (g2 & 63) : (g2 & (SEQ - 1)), sq = smp ? 2 + (g2 >> 6) : (g2 >> 14), slen = smp ? SS : SEQ;
                        if (ok && (tseq < 2 || tseq >= slen - 2)) {
                            float* co = (tseq < 2) ? side + ((size_t)sq * 2 + tseq) * NUP : (smp ? sconv + ((size_t)(sq - 2) * 2 + (tseq - (SS - 2))) * NUP : pconv + ((size_t)sq * 2 + (tseq - (SEQ - 2))) * NUP);
                            *(f32x4*)(co + col) = v;
                        }
                        }
                        acc[ai][bj][m][n] = w0 * p2 + (w1 * p1 + (w2 * v + bb));
                        asm volatile("" : "+v"(acc[ai][bj][m][n]));
                    }
                }
                __builtin_amdgcn_sched_barrier(0);
            }
        int wr = wr_, wc = wc_, fr = fr_, fq = fq_;
        asm volatile("" : "+v"(fr), "+v"(fq));
        asm volatile("" : "+s"(wr), "+s"(wc));
        const int colA = 128 * u.pn + 32 * wc + 8 * fq;
#pragma unroll
        for (int ai = 0; ai < 2; ++ai)
#pragma unroll
            for (int m = 0; m < 4; ++m) {
                const int R = 128 * ai + 64 * wr + 16 * m + fr, grow = 254 * u.pm + R - 2;
                u32x4 w;
#pragma unroll
                for (int n = 0; n < 2; ++n) { const f32x4 ca = acc[ai][0][m][n], cg = acc[ai][1][m][n]; f32x4 r;
#pragma unroll
                    for (int c = 0; c < 4; ++c) r[c] = ca[c] * __builtin_amdgcn_rcpf(1.f + __expf(-ca[c])) * cg[c];
                    if (n == 0) { w.x = cvtpk(r[0], r[1]); w.y = cvtpk(r[2], r[3]); } else { w.z = cvtpk(r[0], r[1]); w.w = cvtpk(r[2], r[3]); } }
                if (R >= 2 && grow < MT) __builtin_nontemporal_store(w, (u32x4*)(ACT + (size_t)grow * DFF + colA));
            }
    }
};
}
#define XB_TMO      128
#define XB_XCNT(j)  (256  + 64 * (j))
#define XB_XSUB(j)  (1280 + 64 * (j))
#define XB_XGEN(j)  (2304 + 64 * (j))
#define XB_TOP      3328
#define XB_TOPGEN   3392
#define XCD_BAR_WORDS 3456
#define XB_SPIN_CAP (1u << 23)
__device__ __forceinline__ unsigned xb_ld(unsigned* p)              { return __hip_atomic_load(p, __ATOMIC_RELAXED, __HIP_MEMORY_SCOPE_AGENT); }
__device__ __forceinline__ unsigned xb_add(unsigned* p, unsigned v) { return __hip_atomic_fetch_add(p, v, __ATOMIC_RELAXED, __HIP_MEMORY_SCOPE_AGENT); }
__device__ __forceinline__ unsigned xb_xcc_id() { return (unsigned)__builtin_amdgcn_s_getreg((3 << 11) | 20) & 0xFu; }
#define XB_SPIN(cond, bar) do { unsigned _sp = 0; while (cond) { __builtin_amdgcn_s_sleep(1); \
    if ((++_sp & 255u) == 0u) { if (xb_ld(&(bar)[XB_TMO])) break; if (_sp > XB_SPIN_CAP) { atomicAdd(&(bar)[XB_TMO], 1u); break; } } } } while (0)
struct XcdBarrier { unsigned* bar; unsigned x; volatile LAS unsigned* st; };
__device__ __forceinline__ XcdBarrier xcd_barrier_post(unsigned* bar, volatile LAS unsigned* st) {
    XcdBarrier b; b.bar = bar; b.x = xb_xcc_id(); b.st = st;
    if (threadIdx.x == 0) (void)xb_add(&bar[XB_XCNT(b.x)], 1u);
    return b;
}
__device__ __forceinline__ void xcd_barrier_complete(unsigned* bar, unsigned x, unsigned& nloc, unsigned& nx) {
    const unsigned G = gridDim.x * gridDim.y * gridDim.z;
    unsigned sum, cnt, mine, sp = 0u;
    for (;;) {
        sum = 0u; cnt = 0u; mine = 0u;
#pragma unroll
        for (unsigned j = 0; j < 16; ++j) { const unsigned c = xb_ld(&bar[XB_XCNT(j)]); sum += c; cnt += (c > 0u) ? 1u : 0u; mine = (j == x) ? c : mine; }
        if (sum == G) break;
        __builtin_amdgcn_s_sleep(1);
        if ((++sp & 255u) == 0u) { if (xb_ld(&bar[XB_TMO])) break; if (sp > XB_SPIN_CAP) { atomicAdd(&bar[XB_TMO], 1u); break; } }
    }
    nloc = mine > 0u ? mine : 1u; nx = cnt > 0u ? cnt : 1u;
}
__device__ __forceinline__ void xcd_barrier(const XcdBarrier& b) {
    asm volatile("s_waitcnt vmcnt(0)" ::: "memory");
    __syncthreads();
    if (threadIdx.x == 0) {
        unsigned* bar = b.bar;
        __builtin_amdgcn_s_waitcnt(0);
        unsigned nloc = b.st[0], nx = b.st[1];
        if (nloc == 0u) { xcd_barrier_complete(bar, b.x, nloc, nx); b.st[0] = nloc; b.st[1] = nx; }
        const unsigned old = xb_add(&bar[XB_XSUB(b.x)], 1u);
        const unsigned gen = old / nloc;
        if (old + 1u == (gen + 1u) * nloc) {
            __builtin_amdgcn_fence(__ATOMIC_RELEASE, "agent");
            asm volatile("s_waitcnt vmcnt(0)" ::: "memory");
            const unsigned og = xb_add(&bar[XB_TOP], 1u);
            const unsigned tg = og / nx;
            if (og + 1u == (tg + 1u) * nx) xb_add(&bar[XB_TOPGEN], 1u);
            else XB_SPIN(xb_ld(&bar[XB_TOPGEN]) == tg, bar);
            __builtin_amdgcn_fence(__ATOMIC_ACQUIRE, "agent");
            xb_add(&bar[XB_XGEN(b.x)], 1u);
            asm volatile("s_waitcnt vmcnt(0)" ::: "memory");
        } else {
            XB_SPIN(xb_ld(&bar[XB_XGEN(b.x)]) == gen, bar);
            __builtin_amdgcn_fence(__ATOMIC_ACQUIRE, "agent");
            asm volatile("s_waitcnt vmcnt(0)" ::: "memory");
        }
    }
    __syncthreads();
}

struct MapIn  { __device__ __forceinline__ int operator()(int c) const { if (c < 1024) return c; if (c < 1088) { const int i = c - 1024; return 4096 + 2 * (i & 31) + (i >> 5); } return c - 64; } };
struct MapUq  { __device__ __forceinline__ int operator()(int c) const { const int hd = c / 192, j = c - hd * 192; if (j < 128) return c; const int i = j - 128; return hd * 192 + 128 + 2 * (i & 31) + (i >> 5); } };
struct MapOff { int off; __device__ __forceinline__ int operator()(int c) const { return c + off; } };
struct MapUp  { __device__ __forceinline__ int operator()(int c) const { if (c < DFF) return 256 * (c >> 7) + (c & 127); const int d = c - DFF; return 256 * (d >> 7) + 128 + (d & 127); } };

template <class MAP>
__device__ __forceinline__ void transpose_item(const float* W, int K, int N, bf16_t* WT, LAS float* scr, int item, int lane, MAP map, const float* gk = nullptr) {
    const int nblk = N / 32, kb = item / nblk, nb = item - kb * nblk, k0 = 64 * kb, n0 = 32 * nb;
    float tv[32];
#pragma unroll
    for (int i = 0; i < 32; ++i) { const int kk = 2 * i + (lane >> 5); tv[i] = __builtin_nontemporal_load(W + (size_t)(k0 + kk) * N + n0 + (lane & 31)); }
#pragma unroll
    for (int i = 0; i < 32; ++i) { const int kk = 2 * i + (lane >> 5); scr[kk * 33 + (lane & 31)] = tv[i]; }
    LDS_WAIT(); asm volatile("" ::: "memory");
    const int c = lane & 7;
    f32x4 g0 = {1.f, 1.f, 1.f, 1.f}, g1 = g0;
    if (gk) { g0 = *(const f32x4*)(gk + k0 + 8 * c); g1 = *(const f32x4*)(gk + k0 + 8 * c + 4); }
#pragma unroll
    for (int j = 0; j < 4; ++j) { const int n = (lane >> 3) + 8 * j; const LAS float* s = scr + (8 * c) * 33 + n;
        u32x4 o; o.x = cvtpk(s[0 * 33] * g0[0], s[1 * 33] * g0[1]); o.y = cvtpk(s[2 * 33] * g0[2], s[3 * 33] * g0[3]); o.z = cvtpk(s[4 * 33] * g1[0], s[5 * 33] * g1[1]); o.w = cvtpk(s[6 * 33] * g1[2], s[7 * 33] * g1[3]);
        *(u32x4*)(WT + (size_t)map(n0 + n) * K + k0 + 8 * c) = o; }
    LDS_WAIT(); asm volatile("" ::: "memory");
}

__device__ __forceinline__ void prep_row_f32(const float* xrow, bf16_t* orow, float* ssq, int lane) {
    const f32x4* xr = (const f32x4*)xrow + lane;
    f32x4 v[8]; float s = 0.f;
#pragma unroll
    for (int j = 0; j < 8; ++j) v[j] = __builtin_nontemporal_load(xr + 64 * j);
#pragma unroll
    for (int j = 0; j < 8; ++j) s += (v[j][0] * v[j][0] + v[j][1] * v[j][1]) + (v[j][2] * v[j][2] + v[j][3] * v[j][3]);
    s = wave_sum(s);
    if (lane == 0) *ssq = s;
    u32x2* o8 = (u32x2*)orow + lane;
#pragma unroll
    for (int j = 0; j < 8; ++j) { u32x2 w; w.x = cvtpk(v[j][0], v[j][1]); w.y = cvtpk(v[j][2], v[j][3]); o8[64 * j] = w; }
}
__device__ __forceinline__ void prep_row_bf(bf16_t* xrow, float* ssq, int lane, const float* part, int np, size_t pstride) {
    u32x2* xr = (u32x2*)xrow + lane;
    f32x4 v[8]; float s = 0.f;
#pragma unroll
    for (int j = 0; j < 8; ++j) { const u32x2 b = xr[64 * j]; v[j] = (f32x4){bf_lo(b.x), bf_hi(b.x), bf_lo(b.y), bf_hi(b.y)}; }
    for (int sl = 0; sl < np; ++sl) { const f32x4* pr = (const f32x4*)(part + (size_t)sl * pstride) + lane;
#pragma unroll
        for (int j = 0; j < 8; ++j) v[j] += pr[64 * j]; }
#pragma unroll
    for (int j = 0; j < 8; ++j) s += (v[j][0] * v[j][0] + v[j][1] * v[j][1]) + (v[j][2] * v[j][2] + v[j][3] * v[j][3]);
    s = wave_sum(s);
    if (lane == 0) *ssq = s;
#pragma unroll
    for (int j = 0; j < 8; ++j) { u32x2 w; w.x = cvtpk(v[j][0], v[j][1]); w.y = cvtpk(v[j][2], v[j][3]); xr[64 * j] = w; }
}
__device__ __forceinline__ void final_row(const bf16_t* xrow, float* yrow, const float* g, int lane, const float* ssq, const float* part = nullptr, int np = 0, size_t pstride = 0) {
    const u32x2* xr = (const u32x2*)xrow + lane; const f32x4* gr = (const f32x4*)g + lane; f32x4* yr = (f32x4*)yrow + lane;
    f32x4 v[8]; float s = 0.f;
#pragma unroll
    for (int j = 0; j < 8; ++j) { const u32x2 b = xr[64 * j]; v[j] = (f32x4){bf_lo(b.x), bf_hi(b.x), bf_lo(b.y), bf_hi(b.y)}; }
    for (int sl = 0; sl < np; ++sl) { const f32x4* pr = (const f32x4*)(part + (size_t)sl * pstride) + lane;
#pragma unroll
        for (int j = 0; j < 8; ++j) v[j] += pr[64 * j]; }
    if (ssq) s = wave_sum(lane < 32 ? ssq[lane] : 0.f);
    else {
#pragma unroll
        for (int j = 0; j < 8; ++j) s += (v[j][0] * v[j][0] + v[j][1] * v[j][1]) + (v[j][2] * v[j][2] + v[j][3] * v[j][3]);
        s = wave_sum(s);
    }
    const float rstd = 1.0f / sqrtf(s * (1.f / DM) + EPS);
#pragma unroll
    for (int j = 0; j < 8; ++j) { const f32x4 gg = gr[64 * j]; __builtin_nontemporal_store(v[j] * rstd * gg, yr + 64 * j); }
}
__device__ __forceinline__ void cvt_row512(const float* src, bf16_t* dst, int lane) {
    const f32x4 a = __builtin_nontemporal_load((const f32x4*)src + 2 * lane), b = __builtin_nontemporal_load((const f32x4*)src + 2 * lane + 1);
    u32x4 w; w.x = cvtpk(a[0], a[1]); w.y = cvtpk(a[2], a[3]); w.z = cvtpk(b[0], b[1]); w.w = cvtpk(b[2], b[3]);
    *((u32x4*)dst + lane) = w;
}
__device__ __forceinline__ void norm_row512(bf16_t* row, const float* g, float* fout, int lane) {
    const u32x4 r = *((const u32x4*)row + lane);
    float v[8] = {bf_lo(r.x), bf_hi(r.x), bf_lo(r.y), bf_hi(r.y), bf_lo(r.z), bf_hi(r.z), bf_lo(r.w), bf_hi(r.w)};
    float s = 0.f;
#pragma unroll
    for (int i = 0; i < 8; ++i) s += v[i] * v[i];
    const float rstd = 1.0f / sqrtf(wave_sum(s) * (1.f / 512.f) + EPS);
    const f32x4 g0 = *((const f32x4*)g + 2 * lane), g1 = *((const f32x4*)g + 2 * lane + 1);
    f32x4 o0, o1;
#pragma unroll
    for (int i = 0; i < 4; ++i) { o0[i] = v[i] * rstd * g0[i]; o1[i] = v[4 + i] * rstd * g1[i]; }
    u32x4 w; w.x = cvtpk(o0[0], o0[1]); w.y = cvtpk(o0[2], o0[3]); w.z = cvtpk(o1[0], o1[1]); w.w = cvtpk(o1[2], o1[3]);
    *((u32x4*)row + lane) = w;
    if (fout) { *((f32x4*)fout + 2 * lane) = o0; *((f32x4*)fout + 2 * lane + 1) = o1; }
}

__device__ __forceinline__ void kmax_row(const float (&v)[8], int stream, LAS unsigned* kml, int lane) {
    float s = 0.f;
#pragma unroll
    for (int i = 0; i < 8; ++i) s += v[i] * v[i];
    s += __shfl_xor(s, 1); s += __shfl_xor(s, 2); s += __shfl_xor(s, 4); s += __shfl_xor(s, 8);
    if ((lane & 15) == 0) __hip_atomic_fetch_max(kml + stream * 4 + (lane >> 4), __float_as_uint(s), __ATOMIC_RELAXED, __HIP_MEMORY_SCOPE_WORKGROUP);
}
__device__ __forceinline__ void cvt_row512_kmax(const float* src, bf16_t* dst, int lane, int stream, LAS unsigned* kml) {
    const f32x4 a = __builtin_nontemporal_load((const f32x4*)src + 2 * lane), b = __builtin_nontemporal_load((const f32x4*)src + 2 * lane + 1);
    u32x4 w; w.x = cvtpk(a[0], a[1]); w.y = cvtpk(a[2], a[3]); w.z = cvtpk(b[0], b[1]); w.w = cvtpk(b[2], b[3]);
    *((u32x4*)dst + lane) = w;
    const float v[8] = {bf_lo(w.x), bf_hi(w.x), bf_lo(w.y), bf_hi(w.y), bf_lo(w.z), bf_hi(w.z), bf_lo(w.w), bf_hi(w.w)};
    kmax_row(v, stream, kml, lane);
}
__device__ __forceinline__ void kmax_flush(LAS unsigned* kml, unsigned* gk, int tid) {
    __syncthreads();
    if (tid < 40) { const unsigned v = kml[tid]; if (v) __hip_atomic_fetch_max(gk + tid, v, __ATOMIC_RELAXED, __HIP_MEMORY_SCOPE_AGENT); kml[tid] = 0u; }
    __syncthreads();
}

__device__ __forceinline__ void norm512_regs(const u32x4 r, const f32x4 g0, const f32x4 g1, bf16_t* row, float* fout, int lane) {
    float v[8] = {bf_lo(r.x), bf_hi(r.x), bf_lo(r.y), bf_hi(r.y), bf_lo(r.z), bf_hi(r.z), bf_lo(r.w), bf_hi(r.w)};
    float s = 0.f;
#pragma unroll
    for (int i = 0; i < 8; ++i) s += v[i] * v[i];
    const float rstd = 1.0f / sqrtf(wave_sum(s) * (1.f / 512.f) + EPS);
    f32x4 o0, o1;
#pragma unroll
    for (int i = 0; i < 4; ++i) { o0[i] = v[i] * rstd * g0[i]; o1[i] = v[4 + i] * rstd * g1[i]; }
    u32x4 w; w.x = cvtpk(o0[0], o0[1]); w.y = cvtpk(o0[2], o0[3]); w.z = cvtpk(o1[0], o1[1]); w.w = cvtpk(o1[2], o1[3]);
    *((u32x4*)row + lane) = w;
    if (fout) { __builtin_nontemporal_store(o0, (f32x4*)fout + 2 * lane); __builtin_nontemporal_store(o1, (f32x4*)fout + 2 * lane + 1); }
}

__device__ __forceinline__ void ssq_reduce(const float* ssp, float* ssq, int t0, int stride) {
    for (int r = t0; r < MP; r += stride) { const f32x4* p = (const f32x4*)(ssp + (size_t)r * 32); float s = 0.f;
#pragma unroll
        for (int j = 0; j < 8; ++j) { const f32x4 v = p[j]; s += (v[0] + v[1]) + (v[2] + v[3]); }
        ssq[r] = s; }
}
namespace att {
typedef short v4i16_t __attribute__((ext_vector_type(4)));
#ifndef SM_THR
#define SM_THR 8.0f
#endif
constexpr int IMG_K = 0, IMG_V = 16384, IMG_R = 32768, SLOT_BYTES = 40960, NSLOT = 3;
constexpr int OFF_BIAS = NSLOT * SLOT_BYTES, OFF_SLOT = OFF_BIAS + 1040, OFF_DONE = OFF_SLOT + 16, STAGE_ROWB = 272, STAGE_WAVE = 32 * STAGE_ROWB;
static_assert(8 * STAGE_WAVE <= OFF_BIAS && OFF_DONE + 32 <= RING_BYTES, "attention LDS map");
struct Tens { const bf16_t* Q; int qpitch; const bf16_t* K; const bf16_t* KR; const bf16_t* V; bf16_t* HEADS; const float* gh; const float* bias; };
__device__ __forceinline__ s16x4 vtr(const LAS unsigned char* p) { return __builtin_bit_cast(s16x4, __builtin_amdgcn_ds_read_tr16_b64_v4i16((LAS v4i16_t*)p)); }
#define ATT_MFMA(a, b, c) __builtin_amdgcn_mfma_f32_32x32x16_bf16((a), (b), (c), 0, 0, 0)
#define ATT_BAR() do { asm volatile("s_waitcnt lgkmcnt(0)" ::: "memory"); __builtin_amdgcn_s_barrier(); asm volatile("" ::: "memory"); } while (0)

template <int VAR>
__device__ __forceinline__ void attn_unit(LAS unsigned char* lds, const Tens& T, int head, int qrow0, int nw, int krow0, int qrel0, float kmax2) {
    constexpr int DQK = VAR == 0 ? 192 : 128, KS = DQK / 16;
    const int tid = fresh_tid(), w = __builtin_amdgcn_readfirstlane(tid >> 6), lane = tid & 63, r = lane & 31, h = lane >> 5;
    const bool active = w < nw;
    const int qw = qrel0 + 32 * w;
    int t_lo = 0, t_hi;
    if (VAR == 0) t_hi = (qrel0 + 32 * (nw - 1)) >> 6;
    else if (VAR == 1) { t_lo = (qrel0 >> 6) - 8; if (t_lo < 0) t_lo = 0; t_hi = (qrel0 + 32 * (nw - 1)) >> 6; }
    else t_hi = (qrel0 + 32 * (nw - 1) + 30) >> 6;
    const int nt = t_hi - t_lo + 1;
    unsigned oK[2];
#pragma unroll
    for (int i = 0; i < 2; ++i) { const int p = 64 * (w + 8 * i) + lane, row = p >> 4, pos = p & 15, ch = pos ^ (((row & 3) << 2) | ((row >> 2) & 3));
        oK[i] = (unsigned)(((krow0 + row) * 512 + 128 * head + 8 * ch) * 2); }
    unsigned oR = 0;
    if (VAR == 0) { const int p = 64 * w + lane, row = p >> 3, pos = p & 7, ch = pos ^ ((row >> 1) & 7); oR = (unsigned)(((krow0 + row) * 64 + 8 * ch) * 2); }
    const char* gKb = (const char*)T.K; const char* gVb = (const char*)T.V; const char* gRb = (const char*)T.KR;
#define ATT_DMA(kt_, slot_) do { LAS unsigned char* sb_ = lds + (slot_) * SLOT_BYTES + w * 1024; \
        _Pragma("unroll") for (int i_ = 0; i_ < 2; ++i_) { \
            __builtin_amdgcn_global_load_lds((const unsigned*)(gKb + (size_t)(kt_) * 65536 + oK[i_]), (LAS unsigned*)(sb_ + IMG_K + i_ * 8192), 16, 0, 0); \
            __builtin_amdgcn_global_load_lds((const unsigned*)(gVb + (size_t)(kt_) * 65536 + oK[i_]), (LAS unsigned*)(sb_ + IMG_V + i_ * 8192), 16, 0, 0); } \
        if (VAR == 0) __builtin_amdgcn_global_load_lds((const unsigned*)(gRb + (size_t)(kt_) * 8192 + oR), (LAS unsigned*)(sb_ + IMG_R), 16, 0, 0); } while (0)
#define ATT_WAIT_TILE(more_) do { if (more_) { if (VAR == 0) asm volatile("s_waitcnt vmcnt(5)" ::: "memory"); else asm volatile("s_waitcnt vmcnt(4)" ::: "memory"); } else asm volatile("s_waitcnt vmcnt(0)" ::: "memory"); } while (0)
#define ATT_TILE(i_) ((VAR == 2) ? (t_hi - (i_)) : (t_lo + (i_)))
    ATT_DMA(ATT_TILE(0), 0); if (nt > 1) ATT_DMA(ATT_TILE(1), 1);
    bf16x8 qf[KS];
    { const bf16_t* qp = T.Q + (size_t)(qrow0 + 32 * (active ? w : 0) + r) * T.qpitch + head * DQK + 8 * h;
#pragma unroll
      for (int ds = 0; ds < KS; ++ds) qf[ds] = *(const bf16x8*)(qp + 16 * ds); }
    if (VAR == 1) { LAS float* bl = (LAS float*)(lds + OFF_BIAS); if (tid < 257) bl[tid] = T.bias[tid] * LOG2E; }
    volatile LAS int* doneit = (volatile LAS int*)(lds + OFF_DONE);
    float zb = 0.f;
    if (VAR == 2) {
        if (tid < 8) doneit[tid] = (tid < nw) ? 0x7fffffff : -1;
        float qs = 0.f;
#pragma unroll
        for (int ds = 0; ds < KS; ++ds)
#pragma unroll
            for (int e = 0; e < 8; ++e) { const float qv = __uint_as_float(((unsigned)(unsigned short)qf[ds][e]) << 16); qs += qv * qv; }
        qs += __shfl_xor(qs, 32);
        zb = sqrtf(qs * kmax2) * 1.02f + 1.0f;
    }
    bool wdone = false;
    asm volatile("s_waitcnt vmcnt(0)" ::: "memory");
    ATT_BAR();
    f32x16 o[4];
#pragma unroll
    for (int d = 0; d < 4; ++d)
#pragma unroll
        for (int i = 0; i < 16; ++i) o[d][i] = 0.f;
    float m_run = 0.f, l_run = 0.f, carry = 0.f; bool first = true;
    const int i16 = lane & 15, q4 = i16 >> 2, p4 = i16 & 3, blk = (lane >> 4) & 1;
    const int swl = ((r & 3) << 2) | ((r >> 2) & 3);
    const int krow = IMG_K + 256 * r, rrow = IMG_R + 128 * r, rsw = (r >> 1) & 7;
    const int vlow = 2 * blk + (p4 >> 1);
    const int vb0 = IMG_V + 256 * (4 * h + q4) + 16 * (vlow ^ (h & 3)) + 8 * (p4 & 1);
    const int vb1 = IMG_V + 256 * (4 * h + q4 + 8) + 16 * (vlow ^ ((h + 2) & 3)) + 8 * (p4 & 1);
    u32x4 pk[4];
#define ATT_PV(sl_) do { const LAS unsigned char* vs_ = (sl_); \
        _Pragma("unroll") for (int ks_ = 0; ks_ < 4; ++ks_) { const bf16x8 pf_ = __builtin_bit_cast(bf16x8, pk[ks_]); \
            _Pragma("unroll") for (int db_ = 0; db_ < 4; ++db_) { const int dx_ = ((db_ ^ q4) << 6) + 4096 * ks_; \
                const s16x4 lo_ = vtr(vs_ + vb0 + dx_), hi_ = vtr(vs_ + vb1 + dx_); const bf16x8 vf_ = __builtin_shufflevector(lo_, hi_, 0, 1, 2, 3, 4, 5, 6, 7); o[db_] = ATT_MFMA(vf_, pf_, o[db_]); } \
            asm volatile("" ::: "memory"); } } while (0)
    int slot = 0;
    for (int it = 0; it < nt; ++it) {
        if (VAR == 2 && it > 0) { int c = 0;
#pragma unroll
            for (int j = 0; j < 8; ++j) c += (doneit[j] < it) ? 1 : 0;
            if (c == 8) break; }
        const bool more2 = it + 2 < nt;
        { int s2 = slot + 2; if (s2 >= NSLOT) s2 -= NSLOT; if (more2) ATT_DMA(ATT_TILE(it + 2), s2); }
        const int kt = ATT_TILE(it);
        const LAS unsigned char* sl = lds + slot * SLOT_BYTES;
        bool vis;
        if (VAR == 0) vis = kt <= (qw >> 6);
        else if (VAR == 1) vis = kt <= (qw >> 6) && kt >= (qw >> 6) - 8;
        else vis = 64 * kt <= qw + 30;
        if (active && vis && !wdone) {
            f32x16 x0, x1;
#pragma unroll
            for (int i = 0; i < 16; ++i) { x0[i] = 0.f; x1[i] = 0.f; }
            {
                bf16x8 ke0[4], ke1[4], kf0[4], kf1[4];
#define ATT_KLOAD(a0_, a1_, g_) do { _Pragma("unroll") for (int j_ = 0; j_ < 4; ++j_) { const int ds_ = 4 * (g_) + j_; \
                    const LAS unsigned char* ka_ = (ds_ < 8) ? sl + krow + 16 * ((2 * ds_ + h) ^ swl) : sl + rrow + 16 * ((2 * (ds_ - 8) + h) ^ rsw); \
                    const int kstep_ = (ds_ < 8) ? 32 * 256 : 32 * 128;                                         \
                    a0_[j_] = *(const LAS bf16x8*)(ka_); a1_[j_] = *(const LAS bf16x8*)(ka_ + kstep_); } } while (0)
                ATT_KLOAD(ke0, ke1, 0);
                __builtin_amdgcn_sched_barrier(0);
#pragma unroll
                for (int g = 0; g < KS / 4; ++g) {
                    if (g + 1 < KS / 4) { if (g & 1) ATT_KLOAD(ke0, ke1, g + 1); else ATT_KLOAD(kf0, kf1, g + 1); }
#pragma unroll
                    for (int j = 0; j < 4; ++j) { const int ds = 4 * g + j;
                        if (g & 1) { x0 = ATT_MFMA(kf0[j], qf[ds], x0); x1 = ATT_MFMA(kf1[j], qf[ds], x1); } else { x0 = ATT_MFMA(ke0[j], qf[ds], x0); x1 = ATT_MFMA(ke1[j], qf[ds], x1); } }
                    __builtin_amdgcn_sched_barrier(0);
                }
#undef ATT_KLOAD
            }
            if (VAR != 2) {
                if (VAR == 1) {
                    const LAS float* bl = (const LAS float*)(lds + OFF_BIAS);
                    if (qw - (64 * kt + 63) >= 128) { const float bc = bl[256];
#pragma unroll
                        for (int i = 0; i < 16; ++i) { x0[i] += bc; x1[i] += bc; } }
                    else { const int dq = qw + r - 64 * kt - 4 * h + 128;
#pragma unroll
                        for (int i = 0; i < 16; ++i) { int d0 = dq - ((i & 3) + 8 * (i >> 2)); int d1 = d0 - 32;
                            d0 = d0 < 0 ? 0 : (d0 > 256 ? 256 : d0); d1 = d1 < 0 ? 0 : (d1 > 256 ? 256 : d1); x0[i] += bl[d0]; x1[i] += bl[d1]; } }
                }
                float mx = x0[0];
#pragma unroll
                for (int i = 1; i < 16; ++i) mx = fmaxf(mx, x0[i]);
#pragma unroll
                for (int i = 0; i < 16; ++i) mx = fmaxf(mx, x1[i]);
                { const auto sw_ = __builtin_amdgcn_permlane32_swap(__float_as_uint(mx), __float_as_uint(mx), false, false);
                  mx = fmaxf(__uint_as_float(sw_[0]), __uint_as_float(sw_[1])) - m_run; }
                float ps = 0.f;
                const float dlt = first ? mx : (mx > SM_THR ? mx : 0.f);
                const bool moved = __any(first || mx > SM_THR);
                first = false;
                m_run += dlt;
#pragma unroll
                for (int i = 0; i < 16; ++i) { x0[i] = __builtin_amdgcn_exp2f(x0[i] - m_run); x1[i] = __builtin_amdgcn_exp2f(x1[i] - m_run); ps += x0[i] + x1[i]; }
                if (moved) {
                    const float alpha = __builtin_amdgcn_exp2f(-dlt);
                    l_run *= alpha;
#pragma unroll
                    for (int d = 0; d < 4; ++d)
#pragma unroll
                        for (int i = 0; i < 16; ++i) o[d][i] *= alpha;
                }
                l_run += ps;
            } else {
                const int q = qw + r, kbase = 64 * kt + 4 * h;
                const bool diag = (64 * kt + 63 >= qw);
                float tot = 0.f;
#pragma unroll
                for (int kbi = 1; kbi >= 0; --kbi) {
#pragma unroll
                    for (int g = 3; g >= 0; --g) {
                        float zz[4], lk[4]; bool vl[4];
#pragma unroll
                        for (int jj = 0; jj < 4; ++jj) { const int i = 4 * g + jj; zz[jj] = kbi ? x1[i] : x0[i]; vl[jj] = !diag || (kbase + 32 * kbi + 8 * g + jj) < q;
                            const float sp = fmaxf(zz[jj], 0.f) + __builtin_amdgcn_logf(1.f + __builtin_amdgcn_exp2f(-fabsf(zz[jj])));
                            lk[jj] = vl[jj] ? -sp : 0.f; }
                        const float s3 = lk[3], s2 = lk[2] + s3, s1 = lk[1] + s2, s0 = lk[0] + s1;
                        const float tp = __shfl_xor(s0, 32);
                        const float base = carry + tot + (h == 0 ? tp : 0.f);
                        const float sx[4] = {s0, s1, s2, s3};
#pragma unroll
                        for (int jj = 0; jj < 4; ++jj) { const int i = 4 * g + jj; const float wv = vl[jj] ? __builtin_amdgcn_exp2f(zz[jj] + sx[jj] + base) : 0.f; if (kbi) x1[i] = wv; else x0[i] = wv; }
                        tot += s0 + tp;
                    }
                }
                carry += tot;
                if (__all(zb + carry < -150.f)) { wdone = true; if (lane == 0) doneit[w] = it; }
            }
            __builtin_amdgcn_sched_barrier(0);
#pragma unroll
            for (int s2 = 0; s2 < 2; ++s2) {
                pk[s2].x = cvtpk(x0[8 * s2 + 0], x0[8 * s2 + 1]); pk[s2].y = cvtpk(x0[8 * s2 + 2], x0[8 * s2 + 3]); pk[s2].z = cvtpk(x0[8 * s2 + 4], x0[8 * s2 + 5]); pk[s2].w = cvtpk(x0[8 * s2 + 6], x0[8 * s2 + 7]);
                pk[2 + s2].x = cvtpk(x1[8 * s2 + 0], x1[8 * s2 + 1]); pk[2 + s2].y = cvtpk(x1[8 * s2 + 2], x1[8 * s2 + 3]); pk[2 + s2].z = cvtpk(x1[8 * s2 + 4], x1[8 * s2 + 5]); pk[2 + s2].w = cvtpk(x1[8 * s2 + 6], x1[8 * s2 + 7]);
            }
            ATT_PV(sl);
        }
        ATT_WAIT_TILE(more2);
        ATT_BAR();
        if (++slot == NSLOT) slot = 0;
    }
    asm volatile("s_waitcnt vmcnt(0)" ::: "memory"); ATT_BAR();
#undef ATT_PV
    if (active) {
        float inv = 1.f;
        if (VAR != 2) { const float l = l_run + __shfl_xor(l_run, 32); inv = 1.f / l; }
        float ss = 0.f;
#pragma unroll
        for (int d = 0; d < 4; ++d)
#pragma unroll
            for (int i = 0; i < 16; ++i) { o[d][i] *= inv; ss += o[d][i] * o[d][i]; }
        ss += __shfl_xor(ss, 32);
        const float rstd = 1.0f / sqrtf(ss * (1.f / 128.f) + EPS);
        LAS unsigned char* st = lds + w * STAGE_WAVE;
#pragma unroll
        for (int d = 0; d < 4; ++d)
#pragma unroll
            for (int g = 0; g < 4; ++g) { const int d0 = 32 * d + 8 * g + 4 * h; const f32x4 gv = *(const f32x4*)(T.gh + d0);
                u32x2 pkk; pkk.x = cvtpk(o[d][4 * g] * rstd * gv[0], o[d][4 * g + 1] * rstd * gv[1]); pkk.y = cvtpk(o[d][4 * g + 2] * rstd * gv[2], o[d][4 * g + 3] * rstd * gv[3]);
                *(LAS u32x2*)(st + r * STAGE_ROWB + d0 * 2) = pkk; }
        LDS_WAIT(); asm volatile("" ::: "memory");
#pragma unroll
        for (int j = 0; j < 8; ++j) { const int c = lane + 64 * j, row = c >> 4, cc = c & 15;
            const u32x4 v = *(const LAS u32x4*)(st + row * STAGE_ROWB + cc * 16);
            *(u32x4*)(T.HEADS + (size_t)(qrow0 + 32 * w + row) * NMIX + (VAR * 4 + head) * 128 + cc * 8) = v; }
    }
#undef ATT_DMA
#undef ATT_WAIT_TILE
#undef ATT_TILE
}

template <int VAR>
__device__ __forceinline__ void attn_queue(LAS unsigned char* lds, const Tens& T, unsigned* ctr8, int xcc, const float* gheads, const float* relbias, const unsigned* kmaxw) {
    volatile LAS unsigned* slot = (volatile LAS unsigned*)(lds + OFF_SLOT);
    for (;;) {
        __syncthreads();
        if (threadIdx.x == 0) {
            unsigned got = 0xffffffffu;
            for (int qi = 0; qi < 8; ++qi) { const int list = (xcc + qi) & 7;
                if (__hip_atomic_load(ctr8 + list * 64, __ATOMIC_RELAXED, __HIP_MEMORY_SCOPE_AGENT) >= 68u) continue;
                const unsigned u = __hip_atomic_fetch_add(ctr8 + list * 64, 1u, __ATOMIC_RELAXED, __HIP_MEMORY_SCOPE_AGENT);
                if (u < 68u) { got = ((unsigned)list << 8) | u; break; } }
            *slot = got;
        }
        __syncthreads();
        const unsigned g = (unsigned)__builtin_amdgcn_readfirstlane((int)*slot);
        if (g == 0xffffffffu) break;
        const int list = (int)(g >> 8), u = (int)(g & 255u);
        int head, qrow0, nw, krow0, qrel0, stream;
        if (u < 64) { const int qb = 63 - u, b = list >> 2; head = list & 3; qrow0 = b * SEQ + 256 * qb; nw = 8; krow0 = b * SEQ; qrel0 = 256 * qb; stream = b; }
        else { const int j = list * 4 + (u - 64), b = j >> 2; head = j & 3; qrow0 = MP + 64 * b; nw = 2; krow0 = MP + b * (VAR == 1 ? BSTR : CSTR); qrel0 = (VAR == 1) ? 512 : PAST; stream = 2 + b; }
        Tens t = T; t.gh = gheads + (VAR * 4 + head) * 128; t.bias = relbias + head * 257;
        float kmax2 = 0.f;
        if (VAR == 2) kmax2 = __uint_as_float(__hip_atomic_load(kmaxw + stream * 4 + head, __ATOMIC_RELAXED, __HIP_MEMORY_SCOPE_AGENT));
        attn_unit<VAR>(lds, t, head, qrow0, nw, krow0, qrel0, kmax2);
    }
}
}
__constant__ float c_inv_freq[32] = {1.000000000e+00f, 7.498942614e-01f, 5.623413324e-01f, 4.216965139e-01f, 3.162277639e-01f, 2.371373773e-01f, 1.778279394e-01f, 1.333521307e-01f,
    1.000000015e-01f, 7.498941571e-02f, 5.623413250e-02f, 4.216965288e-02f, 3.162277490e-02f, 2.371373773e-02f, 1.778279431e-02f, 1.333521493e-02f,
    9.999999776e-03f, 7.498941850e-03f, 5.623413250e-03f, 4.216964822e-03f, 3.162277630e-03f, 2.371373586e-03f, 1.778279431e-03f, 1.333521446e-03f,
    1.000000047e-03f, 7.498942432e-04f, 5.623413017e-04f, 4.216965172e-04f, 3.162277571e-04f, 2.371373703e-04f, 1.778279402e-04f, 1.333521504e-04f};

#ifndef PHASE_MASK
#define PHASE_MASK 0xFFFF
#endif
#ifndef WGM_RES
#define WGM_RES 4
#endif
#ifndef DUP_A
#define DUP_A 0
#endif
#ifndef DUP_UP
#define DUP_UP 0
#endif
#ifndef DUP_IN
#define DUP_IN 0
#endif
#ifndef DUP_W
#define DUP_W 0
#endif
#ifndef DUP_BC
#define DUP_BC 0
#endif
#ifndef DUP_N2
#define DUP_N2 0
#endif
#ifndef FILL_IN
#define FILL_IN 8
#endif
#ifndef FILL_UP
#define FILL_UP 11
#endif
struct Args { const float* in[25]; float* out; unsigned char* ws; };

constexpr int PTAB_OFF = RING_BYTES + 1024;
__device__ __forceinline__ const void* ldptr(volatile LAS unsigned long long* t_, int k) {
    unsigned tb = (unsigned)(size_t)t_; asm volatile("" : "+s"(tb));
    volatile LAS unsigned long long* t = (volatile LAS unsigned long long*)(size_t)tb;
    const unsigned long long v = t[k];
    const unsigned lo = (unsigned)__builtin_amdgcn_readfirstlane((int)(unsigned)v), hi = (unsigned)__builtin_amdgcn_readfirstlane((int)(unsigned)(v >> 32));
    return (const void*)(GAS const unsigned char*)(((unsigned long long)hi << 32) | lo);
}
#define P_IN(k) ((const float*)ldptr(ptab, (k)))
#define P_OUT() ((float*)ldptr(ptab, 25))
#define P_WS() ((unsigned char*)ldptr(ptab, 26))

__global__ void __launch_bounds__(512, 2) fwd_kernel(Args args) {
    extern __shared__ __attribute__((aligned(16))) unsigned char lds_raw[];
    LAS unsigned char* lds = (LAS unsigned char*)lds_raw;
    volatile LAS unsigned* MISC = (volatile LAS unsigned*)(lds + MISC_OFF);
    volatile LAS unsigned long long* ptab = (volatile LAS unsigned long long*)(lds + PTAB_OFF);
    const int tid = threadIdx.x;
    const int G = gridDim.x, NGW = G * 8;
    for (int u = tid; u < (LDS_BYTES - RING_BYTES) / 4; u += 512) ((LAS unsigned*)(lds + RING_BYTES))[u] = 0u;
    __syncthreads();
    if (tid < 25) ptab[tid] = (unsigned long long)args.in[tid];
    if (tid == 25) ptab[25] = (unsigned long long)args.out;
    if (tid == 26) ptab[26] = (unsigned long long)args.ws;
    __syncthreads();
    XcdBarrier bar = xcd_barrier_post((unsigned*)(args.ws + WS_CTL) + CW_BAR, MISC + 8);

    {
        f32x2* ROPE = (f32x2*)(P_WS() + WS_ROPE);
        for (int e = blockIdx.x * 512 + tid; e < SEQ * 32; e += G * 512) {
            const int pos = e >> 5, i = e & 31;
            const float ang = (float)pos * c_inv_freq[i];
            const double rev = (double)ang * 0.15915494309189535; const float fr = (float)(rev - floor(rev));
            ROPE[e] = (f32x2){__builtin_amdgcn_cosf(fr), __builtin_amdgcn_sinf(fr)};
        }
    }

    constexpr int I_IN = 32 * 130, I_UQ = 8 * 24, I_UK = 8 * 16, I_OUT = 24 * 64, I_UP = 32 * 352, I_DN = 88 * 64, I_ALL = I_IN + I_UQ + 2 * I_UK + I_OUT + I_UP + I_DN;
    auto w_items = [&](int lt, int wv, int stride, int lo, int hi) __attribute__((always_inline)) {
        const int tid = fresh_tid(), lane = tid & 63, wave = __builtin_amdgcn_readfirstlane(tid >> 6);
        unsigned char* ws = P_WS() + ((lt & 1) ? WALT : 0);
        LAS float* scr = (LAS float*)(lds + wave * 16384);
        for (int it = lo + wv; it < hi; it += stride) {
            int r = it;
            if (r < I_IN) { transpose_item(P_IN(10) + (size_t)lt * DM * 4160, DM, 4160, (bf16_t*)(ws + WS_WIN), scr, r, lane, MapIn{}, P_IN(9) + (size_t)lt * DM); continue; } r -= I_IN;
            if (r < I_UQ) { transpose_item(P_IN(12) + (size_t)lt * 512 * 768, 512, 768, (bf16_t*)(ws + WS_WUQ), scr, r, lane, MapUq{}); continue; } r -= I_UQ;
            if (r < I_UK) { transpose_item(P_IN(14) + (size_t)lt * 512 * 512, 512, 512, (bf16_t*)(ws + WS_WKV), scr, r, lane, MapOff{0}); continue; } r -= I_UK;
            if (r < I_UK) { transpose_item(P_IN(15) + (size_t)lt * 512 * 512, 512, 512, (bf16_t*)(ws + WS_WKV), scr, r, lane, MapOff{512}); continue; } r -= I_UK;
            if (r < I_OUT) { transpose_item(P_IN(18) + (size_t)lt * NMIX * DM, NMIX, DM, (bf16_t*)(ws + WS_WOUT), scr, r, lane, MapOff{0}); continue; } r -= I_OUT;
            if (r < I_UP) { transpose_item(P_IN(20) + (size_t)lt * DM * NUP, DM, NUP, (bf16_t*)(ws + WS_WUP), scr, r, lane, MapUp{}, P_IN(19) + (size_t)lt * DM); continue; } r -= I_UP;
            transpose_item(P_IN(23) + (size_t)lt * DFF * DM, DFF, DM, (bf16_t*)(ws + WS_WDN), scr, r, lane, MapOff{0});
        }
    };
    const int idle_in = (MT / 256 * (NIN / 256)) % G, idle_up = (132 * (NUP / 256)) % G;
    const int n_in = idle_in ? (G - idle_in) * 8 : 0, n_up = idle_up ? (G - idle_up) * 8 : 0;
    int F1 = n_in * FILL_IN; if (F1 > I_ALL) F1 = I_ALL;
    int F2 = F1 + n_up * FILL_UP; if (F2 > I_ALL) F2 = I_ALL;

    for (int l = 0; l < DEPTH; ++l) {
        if (PHASE_MASK & (1 << 0))
        for (int rep = 0; rep < 1 + DUP_W; ++rep)
        {
            const int tid = fresh_tid(), lane = tid & 63, wave = __builtin_amdgcn_readfirstlane(tid >> 6), gw = blockIdx.x * 8 + wave;
            unsigned char* ws = P_WS();
            w_items(l, gw, NGW, l == 0 ? 0 : F2, I_ALL);
            for (int it = gw; it < 40960; it += NGW) {
                if (it < 8192) { const int b = it >> 10, t = it & 1023; cvt_row512(P_IN(2) + ((size_t)(l * SB + b) * PAST + t) * 512, (bf16_t*)(ws + WS_CKV) + (size_t)(MP + b * CSTR + t) * 512, lane); }
                else if (it < 16384) { const int j = it - 8192, b = j >> 10, t = j & 1023;
                    if (lane < 32) { const float* s = P_IN(3) + ((size_t)(l * SB + b) * PAST + t) * 64; ((unsigned*)((bf16_t*)(ws + WS_KR) + (size_t)(MP + b * CSTR + t) * 64))[lane] = cvtpk(s[lane], s[lane + 32]); } }
                else if (it < 20480) { const int j = it - 16384, b = j >> 9, t = j & 511; cvt_row512(P_IN(4) + ((size_t)(l * SB + b) * 512 + t) * 512, (bf16_t*)(ws + WS_KB) + (size_t)(MP + b * BSTR + t) * 512, lane); }
                else if (it < 24576) { const int j = it - 20480, b = j >> 9, t = j & 511; cvt_row512(P_IN(5) + ((size_t)(l * SB + b) * 512 + t) * 512, (bf16_t*)(ws + WS_VB) + (size_t)(MP + b * BSTR + t) * 512, lane); }
                else if (it < 32768) { const int j = it - 24576, b = j >> 10, t = j & 1023; cvt_row512_kmax(P_IN(6) + ((size_t)(l * SB + b) * PAST + t) * 512, (bf16_t*)(ws + WS_KC) + (size_t)(MP + b * CSTR + t) * 512, lane, 2 + b, (LAS unsigned*)(lds + KMAXL_OFF)); }
                else { const int j = it - 32768, b = j >> 10, t = j & 1023; cvt_row512(P_IN(7) + ((size_t)(l * SB + b) * PAST + t) * 512, (bf16_t*)(ws + WS_VC) + (size_t)(MP + b * CSTR + t) * 512, lane); }
            }
            {
                bf16_t* XB = (bf16_t*)(ws + WS_H); float* ssq = (float*)(ws + WS_SSQ) + (size_t)(l * 2 + 0) * MT;
                if (l == 0) { const float* xp = P_IN(0); const float* xs = P_IN(1);
                    for (int m = gw; m < MT; m += NGW) prep_row_f32(m < MP ? xp + (size_t)m * DM : xs + (size_t)(m - MP) * DM, XB + (size_t)m * DM, ssq + m, lane); }
                else { const float* part = (const float*)(ws + WS_PART);
                    for (int m = MP + gw; m < MT; m += NGW) prep_row_bf(XB + (size_t)m * DM, ssq + m, lane, part + (size_t)(m - MP) * DM, NS_DOWN, (size_t)MS * DM);
                    ssq_reduce((const float*)(ws + WS_SSP), ssq, blockIdx.x * 512 + tid, G * 512); }
            }
            kmax_flush((LAS unsigned*)(lds + KMAXL_OFF), (unsigned*)(ws + WS_CTL) + CW_KMAX + l * 64, tid);
        }
        xcd_barrier(bar);

        if (PHASE_MASK & (1 << 1))
        for (int rep = 0; rep < 1 + DUP_IN; ++rep)
        {
            unsigned char* ws = P_WS();
            pg8::Gemm g{(const bf16_t*)(ws + WS_H), (const bf16_t*)(ws + ((l & 1) ? WALT : 0) + WS_WIN), DM}; pg8::StaticOrder S; S.init(MT / 256, NIN / 256, G, (int)blockIdx.x, DM / 64);
            pg8::EpiIn E{ws, P_OUT(), l, (const float*)(ws + WS_SSQ) + (size_t)(l * 2 + 0) * MT};
            pg8::gemm_phase<pg8::EpiIn, pg8::StaticOrder, 0>(lds, g, S, E);
            if (rep == 0 && l + 1 < DEPTH && idle_in && (int)blockIdx.x >= idle_in) { __syncthreads(); w_items(l + 1, ((int)blockIdx.x - idle_in) * 8 + __builtin_amdgcn_readfirstlane((int)(fresh_tid() >> 6)), n_in, 0, F1); }
        }
        xcd_barrier(bar);

        if (PHASE_MASK & (1 << 2))
        {
            const int tid = fresh_tid(), lane = tid & 63, wave = __builtin_amdgcn_readfirstlane(tid >> 6), gw = blockIdx.x * 8 + wave;
            unsigned char* ws = P_WS(); float* out = P_OUT(); const float* gq = P_IN(11) + (size_t)l * 512; const float* gkv = P_IN(13) + (size_t)l * 512;
            bf16_t *CQ = (bf16_t*)(ws + WS_CQ), *CKV = (bf16_t*)(ws + WS_CKV), *KR = (bf16_t*)(ws + WS_KR); const f32x2* ROPE = (const f32x2*)(ws + WS_ROPE);
            const f32x4 gq0 = *((const f32x4*)gq + 2 * lane), gq1 = *((const f32x4*)gq + 2 * lane + 1), gk0 = *((const f32x4*)gkv + 2 * lane), gk1 = *((const f32x4*)gkv + 2 * lane + 1);
            const bf16_t* KC = (const bf16_t*)(ws + WS_KC);
            for (int m0 = 2 * gw; m0 < MT; m0 += 2 * NGW) {
                u32x4 rq[2], rk[2], rc[2]; unsigned rr[2] = {0u, 0u}; f32x2 cs[2] = {{0.f, 0.f}, {0.f, 0.f}}; int rowc[2];
#pragma unroll
                for (int j = 0; j < 2; ++j) { const int m = m0 + j; rowc[j] = pg8::map_c(m);
                    rq[j] = *((const u32x4*)(CQ + (size_t)m * 512) + lane); rk[j] = *((const u32x4*)(CKV + (size_t)rowc[j] * 512) + lane); rc[j] = *((const u32x4*)(KC + (size_t)rowc[j] * 512) + lane);
                    if (lane < 32) { const int pos = m >= MP ? PAST + ((m - MP) & 63) : (m & (SEQ - 1)); rr[j] = *((const unsigned*)(KR + (size_t)rowc[j] * 64) + lane); cs[j] = ROPE[(size_t)pos * 32 + lane]; } }
#pragma unroll
                for (int j = 0; j < 2; ++j) { const int m = m0 + j; const bool smp = m >= MP; const int ms = m - MP;
                    norm512_regs(rq[j], gq0, gq1, CQ + (size_t)m * 512, nullptr, lane);
                    float* ockv = smp ? out + O_SACKV + ((size_t)l * MS + ms) * 512 : out + O_PACKV + ((size_t)l * MP + m) * 512;
                    norm512_regs(rk[j], gk0, gk1, CKV + (size_t)rowc[j] * 512, ockv, lane);
                    if (lane < 32) {
                        const float x1 = bf_lo(rr[j]), x2 = bf_hi(rr[j]);
                        const float o1 = x1 * cs[j][0] - x2 * cs[j][1], o2 = x1 * cs[j][1] + x2 * cs[j][0];
                        *((unsigned*)(KR + (size_t)rowc[j] * 64) + lane) = cvtpk(o1, o2);
                        float* okr = smp ? out + O_SAKR + ((size_t)l * MS + ms) * 64 : out + O_PAKR + ((size_t)l * MP + m) * 64;
                        okr[lane] = o1; okr[lane + 32] = o2;
                    }
                    {
                        const u32x4 r = rc[j];
                        const float v[8] = {bf_lo(r.x), bf_hi(r.x), bf_lo(r.y), bf_hi(r.y), bf_lo(r.z), bf_hi(r.z), bf_lo(r.w), bf_hi(r.w)};
                        kmax_row(v, smp ? 2 + (ms >> 6) : (m >> 14), (LAS unsigned*)(lds + KMAXL_OFF), lane);
                    }
                }
            }
            kmax_flush((LAS unsigned*)(lds + KMAXL_OFF), (unsigned*)(ws + WS_CTL) + CW_KMAX + l * 64, tid);
        }
        xcd_barrier(bar);

        if (PHASE_MASK & (1 << 3))
        {
            unsigned char* ws = P_WS();
            pg8::Gemm g{(const bf16_t*)(ws + WS_CQ), (const bf16_t*)(ws + ((l & 1) ? WALT : 0) + WS_WUQ), 512}; pg8::StaticOrder S; S.init(MT / 256, 3, G, (int)blockIdx.x, 8);
            pg8::EpiQ E{(bf16_t*)(ws + WS_QA), (const f32x2*)(ws + WS_ROPE)};
            pg8::gemm_phase<pg8::EpiQ, pg8::StaticOrder, 0>(lds, g, S, E);
        }
        if (PHASE_MASK & (1 << 4))
        {
            unsigned char* ws = P_WS();
            pg8::Gemm g{(const bf16_t*)(ws + WS_CKV), (const bf16_t*)(ws + ((l & 1) ? WALT : 0) + WS_WKV), 512}; pg8::StaticOrder S; S.init(MC / 256, 4, G, (int)blockIdx.x, 8);
            pg8::EpiKV E{(bf16_t*)(ws + WS_KA), (bf16_t*)(ws + WS_VA)};
            pg8::gemm_phase<pg8::EpiKV, pg8::StaticOrder, 0>(lds, g, S, E);
        }
        xcd_barrier(bar);

        if (PHASE_MASK & (1 << 5))
        for (int rep = 0; rep < 1 + DUP_BC; ++rep)
        {   unsigned char* ws = P_WS();
            att::Tens T{(const bf16_t*)(ws + WS_QC), 512, (const bf16_t*)(ws + WS_KC), nullptr, (const bf16_t*)(ws + WS_VC), (bf16_t*)(ws + WS_HEADS), nullptr, nullptr};
            att::attn_queue<2>(lds, T, (unsigned*)(ws + WS_CTL) + CW_Q + ((rep ? 12 + l : l * 3 + 0) * 8) * 64, (int)bar.x, P_IN(17) + (size_t)l * NMIX, P_IN(16) + (size_t)l * 4 * 257, (const unsigned*)(ws + WS_CTL) + CW_KMAX + l * 64); }
        if (PHASE_MASK & (1 << 6))
        for (int rep = 0; rep < 1 + DUP_A; ++rep)
        {   unsigned char* ws = P_WS();
            att::Tens T{(const bf16_t*)(ws + WS_QA), 768, (const bf16_t*)(ws + WS_KA), (const bf16_t*)(ws + WS_KR), (const bf16_t*)(ws + WS_VA), (bf16_t*)(ws + WS_HEADS), nullptr, nullptr};
            att::attn_queue<0>(lds, T, (unsigned*)(ws + WS_CTL) + CW_Q + ((rep ? 16 + l : l * 3 + 1) * 8) * 64, (int)bar.x, P_IN(17) + (size_t)l * NMIX, P_IN(16) + (size_t)l * 4 * 257, nullptr); }
        if (PHASE_MASK & (1 << 7))
        for (int rep = 0; rep < 1 + DUP_BC; ++rep)
        {   unsigned char* ws = P_WS();
            att::Tens T{(const bf16_t*)(ws + WS_QB), 512, (const bf16_t*)(ws + WS_KB), nullptr, (const bf16_t*)(ws + WS_VB), (bf16_t*)(ws + WS_HEADS), nullptr, nullptr};
            att::attn_queue<1>(lds, T, (unsigned*)(ws + WS_CTL) + CW_Q + ((rep ? 20 + l : l * 3 + 2) * 8) * 64, (int)bar.x, P_IN(17) + (size_t)l * NMIX, P_IN(16) + (size_t)l * 4 * 257, nullptr); }
        xcd_barrier(bar);

        if (PHASE_MASK & (1 << 8))
        {
            unsigned char* ws = P_WS();
            pg8::Gemm g{(const bf16_t*)(ws + WS_HEADS), (const bf16_t*)(ws + ((l & 1) ? WALT : 0) + WS_WOUT), NMIX}; pg8::TailOrder S; S.init(MP / 256, MS / 256, DM / 256, G, (int)blockIdx.x, NMIX / 64, NS_OUT, WGM_RES);
            pg8::EpiRes E{(bf16_t*)(ws + WS_H), (float*)(ws + WS_PART), NMIX / 64, (float*)(ws + WS_SSP)};
            pg8::gemm_phase<pg8::EpiRes, pg8::TailOrder, 0>(lds, g, S, E);
        }
        xcd_barrier(bar);

        if (PHASE_MASK & (1 << 9))
        for (int rep = 0; rep < 1 + DUP_N2; ++rep)
        {
            const int tid = fresh_tid(), lane = tid & 63, wave = __builtin_amdgcn_readfirstlane(tid >> 6), gw = blockIdx.x * 8 + wave;
            unsigned char* ws = P_WS(); bf16_t* XB = (bf16_t*)(ws + WS_H); const float* part = (const float*)(ws + WS_PART);
            float* ssq = (float*)(ws + WS_SSQ) + (size_t)(l * 2 + 1) * MT;
            for (int m = MP + gw; m < MT; m += NGW) prep_row_bf(XB + (size_t)m * DM, ssq + m, lane, part + (size_t)(m - MP) * DM, NS_OUT, (size_t)MS * DM);
            ssq_reduce((const float*)(ws + WS_SSP), ssq, blockIdx.x * 512 + tid, G * 512);
        }
        xcd_barrier(bar);

        if (PHASE_MASK & (1 << 10))
        for (int rep = 0; rep < 1 + DUP_UP; ++rep)
        {
            unsigned char* ws = P_WS(); float* out = P_OUT();
            pg8::Gemm g{(const bf16_t*)(ws + WS_H) - 2 * DM, (const bf16_t*)(ws + ((l & 1) ? WALT : 0) + WS_WUP), DM}; pg8::StaticOrder S; S.init(132, NUP / 256, G, (int)blockIdx.x, DM / 64);
            pg8::EpiUp E{(bf16_t*)(ws + WS_ACT), P_IN(21) + (size_t)l * 3 * NUP, P_IN(22) + (size_t)l * NUP, (float*)(ws + WS_SIDE), out + O_PCONV + (size_t)l * NB * 2 * NUP, out + O_SCONV + (size_t)l * SB * 2 * NUP, (const float*)(ws + WS_SSQ) + (size_t)(l * 2 + 1) * MT, lds + XCH_OFF};
            pg8::gemm_phase<pg8::EpiUp, pg8::StaticOrder, 2>(lds, g, S, E);
            if (rep == 0 && l + 1 < DEPTH && idle_up && (int)blockIdx.x >= idle_up) { __syncthreads(); w_items(l + 1, ((int)blockIdx.x - idle_up) * 8 + __builtin_amdgcn_readfirstlane((int)(fresh_tid() >> 6)), n_up, F1, F2); }
        }
        xcd_barrier(bar);

        if (PHASE_MASK & (1 << 12))
        {
            const int tid = fresh_tid();
            unsigned char* ws = P_WS(); const float* w_conv = P_IN(21); const float* b_conv = P_IN(22); const float* state_conv = P_IN(8); bf16_t* ACT = (bf16_t*)(ws + WS_ACT);
            for (int e = blockIdx.x * 512 + tid; e < 20 * DFF; e += G * 512) {
                const int rs = e / DFF, j = e - rs * DFF, sq = rs >> 1, ts = rs & 1;
                const float* sd = (const float*)(ws + WS_SIDE) + (size_t)sq * 2 * NUP; const float* wc3 = w_conv + (size_t)l * 3 * NUP; const float* bc = b_conv + (size_t)l * NUP;
                float cv[2];
#pragma unroll
                for (int part = 0; part < 2; ++part) { const int col = part * DFF + j;
                    float s0 = 0.f, s1 = 0.f; if (sq >= 2) { const float* st = state_conv + ((size_t)l * SB + (sq - 2)) * 2 * NUP; s0 = st[col]; s1 = st[NUP + col]; }
                    const float ut = sd[ts * NUP + col], u1 = ts ? sd[col] : s1, u2 = ts ? s1 : s0;
                    cv[part] = bc[col] + wc3[col] * u2 + wc3[NUP + col] * u1 + wc3[2 * NUP + col] * ut; }
                const int row = (sq < 2 ? sq * SEQ : MP + (sq - 2) * SS) + ts;
                const float r = cv[0] * __builtin_amdgcn_rcpf(1.f + __expf(-cv[0])) * cv[1];
                ACT[(size_t)row * DFF + j] = (bf16_t)(cvtpk(r, 0.f) & 0xffffu);
            }
        }
        xcd_barrier(bar);

        if (PHASE_MASK & (1 << 11))
        {
            unsigned char* ws = P_WS();
            pg8::Gemm g{(const bf16_t*)(ws + WS_ACT), (const bf16_t*)(ws + ((l & 1) ? WALT : 0) + WS_WDN), DFF}; pg8::TailOrder S; S.init(MP / 256, MS / 256, DM / 256, G, (int)blockIdx.x, DFF / 64, NS_DOWN, WGM_RES);
            pg8::EpiRes E{(bf16_t*)(ws + WS_H), (float*)(ws + WS_PART), DFF / 64, (float*)(ws + WS_SSP)};
            pg8::gemm_phase<pg8::EpiRes, pg8::TailOrder, 0>(lds, g, S, E);
        }
        xcd_barrier(bar);
    }
    {
        const int tid = fresh_tid(), lane = tid & 63, wave = __builtin_amdgcn_readfirstlane(tid >> 6), gw = blockIdx.x * 8 + wave;
        float* Y = P_OUT(); const float* gfin = P_IN(24);
        unsigned char* ws = P_WS(); const bf16_t* XB = (const bf16_t*)(ws + WS_H); const float* part = (const float*)(ws + WS_PART); const float* ssp = (const float*)(ws + WS_SSP);
        for (int m = gw; m < MT; m += NGW) { if (m < MP) final_row(XB + (size_t)m * DM, Y + (size_t)m * DM, gfin, lane, ssp + (size_t)m * 32); else final_row(XB + (size_t)m * DM, Y + (size_t)m * DM, gfin, lane, nullptr, part + (size_t)(m - MP) * DM, NS_DOWN, (size_t)MS * DM); }
    }
}

extern "C" void kernel_launch(void* const* d_in, const int* in_sizes, int n_in, void* d_out, int out_size, void* d_ws, size_t ws_size, hipStream_t stream) {
    static int grid = 0;
    if (grid == 0) {
        if (n_in != 25 || (size_t)out_size != O_END || ws_size < WS_END) { fprintf(stderr, "kernel_launch: unexpected sizes (n_in %d, out %d, ws %zu; need out %zu, ws >= %zu); nothing launched\n", n_in, out_size, ws_size, (size_t)O_END, (size_t)WS_END); grid = -1; return; }
        int dev = 0, cus = 0, per_cu = 0;
        if (hipGetDevice(&dev) != hipSuccess || hipDeviceGetAttribute(&cus, hipDeviceAttributeMultiprocessorCount, dev) != hipSuccess) { grid = -1; return; }
        if (hipFuncSetAttribute((const void*)fwd_kernel, hipFuncAttributeMaxDynamicSharedMemorySize, LDS_BYTES) != hipSuccess) { fprintf(stderr, "kernel_launch: hipFuncSetAttribute failed\n"); grid = -1; return; }
        if (hipOccupancyMaxActiveBlocksPerMultiprocessor(&per_cu, (const void*)fwd_kernel, 512, LDS_BYTES) != hipSuccess || per_cu < 1) fprintf(stderr, "kernel_launch: occupancy query reports %d\n", per_cu);
        (void)hipGetLastError();
        grid = cus;
    }
    if (grid < 0) return;
    if (hipMemsetAsync((char*)d_ws + WS_CTL, 0, CTL_ZERO_BYTES, stream) != hipSuccess) return;
    Args a{};
    for (int i = 0; i < 25; ++i) a.in[i] = (const float*)d_in[i];
    a.out = (float*)d_out; a.ws = (unsigned char*)d_ws;
    hipLaunchKernelGGL(fwd_kernel, dim3(grid), dim3(512), LDS_BYTES, stream, a);
}
```
